# Optimizing an MI355X kernel written in HIP

```python
import math
import jax, jax.numpy as jnp
from jax import lax
import numpy as np

D_MODEL = 2048
BATCH = 2
SEQ = 16384
DEPTH = 1

HEAD_DIM = 128
NSA_HEADS = 8
NSA_KV_GROUPS = 2
NSA_HPG = NSA_HEADS // NSA_KV_GROUPS
FOX_HEADS = 8
CMP_BLOCK = 32
CMP_STRIDE = 16
SLC_BLOCK = 64
SLC_TOPK = 16
WINDOW = 512
Q_BLOCK = 128
REL_BUCKETS = 32
REL_MAX_DIST = 128
D_FF = 5632
CONV_WIDTH = 3
EPS = 1e-6
NEG_INF = -1e30
FORCED_SCORE = 1e4

NSA_Q_DIM = NSA_HEADS * HEAD_DIM
NSA_KV_DIM = NSA_KV_GROUPS * HEAD_DIM
FOX_DIM = FOX_HEADS * HEAD_DIM
IN_SPLITS = (NSA_Q_DIM, NSA_KV_DIM, NSA_KV_DIM, NSA_KV_DIM, NSA_KV_DIM, NSA_KV_DIM, NSA_KV_DIM,
             3 * NSA_HEADS, FOX_DIM, FOX_DIM, FOX_DIM, FOX_HEADS, D_MODEL, D_MODEL)
D_IN = NSA_Q_DIM + 6 * NSA_KV_DIM + 3 * NSA_HEADS + 3 * FOX_DIM + FOX_HEADS + 2 * D_MODEL

kernel_name = "nsa_fox_gated_hybrid_block"


def rms_norm(x, g):
    xf = x.astype(jnp.float32)
    y = xf * lax.rsqrt(jnp.mean(xf * xf, axis=-1, keepdims=True) + EPS)
    return y.astype(x.dtype) * g


def t5_bucket(dist):
    n = jnp.maximum(dist, 0)
    max_exact = REL_BUCKETS // 2
    nf = jnp.maximum(n, 1).astype(jnp.float32)
    large = max_exact + (jnp.log(nf / max_exact) / math.log(REL_MAX_DIST / max_exact)
                         * (REL_BUCKETS - max_exact)).astype(jnp.int32)
    return jnp.where(n < max_exact, n, jnp.minimum(large, REL_BUCKETS - 1))


def rel_bias_dense(dist, table):
    bias = table[t5_bucket(dist)]
    return bias.transpose(2, 0, 1).reshape(NSA_KV_GROUPS, NSA_HPG, *dist.shape)


def masked_softmax(s, mask):
    p = jax.nn.softmax(jnp.where(mask, s, NEG_INF), axis=-1)
    return jnp.where(mask, p, 0.0)


def compress_tokens(kv, pos, w1, w2):
    bsz, seq, grp, dh = kv.shape
    ch = kv.reshape(bsz, seq // CMP_STRIDE, CMP_STRIDE, grp, dh)
    blocks = jnp.concatenate([ch[:, :-1], ch[:, 1:]], axis=2) + pos[:, None, :]
    flat = blocks.transpose(0, 1, 3, 2, 4).reshape(bsz, -1, grp, CMP_BLOCK * dh)
    return jax.nn.gelu(flat @ w1) @ w2


def causal_dwconv(a, w, bias):
    seq = a.shape[1]
    ap = jnp.pad(a, ((0, 0), (CONV_WIDTH - 1, 0), (0, 0)))
    out = bias
    for k in range(CONV_WIDTH):
        out = out + w[k] * ap[:, k:k + seq]
    return out


def nsa_attention(q, k_cmp, v_cmp, k_slc, v_slc, k_win, v_win, gate_logits,
                  pos_k, w1_k, w2_k, pos_v, w1_v, w2_v, rel_table):
    bsz, seq = q.shape[:2]
    scale = HEAD_DIM ** -0.5
    q = q.reshape(bsz, seq, NSA_KV_GROUPS, NSA_HPG, HEAD_DIM)
    kc = compress_tokens(k_cmp, pos_k, w1_k, w2_k)
    vc = compress_tokens(v_cmp, pos_v, w1_v, w2_v)
    n_cmp = kc.shape[1]
    n_slc = seq // SLC_BLOCK
    top_n = min(SLC_TOPK, n_slc)
    c_start = jnp.arange(n_cmp) * CMP_STRIDE
    c_end = c_start + CMP_BLOCK - 1
    s_start = jnp.arange(n_slc) * SLC_BLOCK
    overlap = ((c_start[:, None] < s_start[None, :] + SLC_BLOCK)
               & (c_end[:, None] >= s_start[None, :])).astype(jnp.float32)
    ks_blk = k_slc.reshape(bsz, n_slc, SLC_BLOCK, NSA_KV_GROUPS, HEAD_DIM).transpose(0, 3, 1, 2, 4)
    vs_blk = v_slc.reshape(bsz, n_slc, SLC_BLOCK, NSA_KV_GROUPS, HEAD_DIM).transpose(0, 3, 1, 2, 4)
    pad = ((0, 0), (WINDOW, 0), (0, 0), (0, 0))
    kw_pad = jnp.pad(k_win, pad)
    vw_pad = jnp.pad(v_win, pad)
    gates = jax.nn.sigmoid(gate_logits).reshape(bsz, seq, NSA_KV_GROUPS, NSA_HPG, 3)
    table_g = rel_table.reshape(REL_BUCKETS, NSA_KV_GROUPS, NSA_HPG)
    b_idx = jnp.arange(bsz)[:, None, None, None]
    g_idx = jnp.arange(NSA_KV_GROUPS)[None, :, None, None]
    blk_ids = jnp.arange(n_slc)

    def query_block(qb):
        t0 = qb * Q_BLOCK
        qblk = lax.dynamic_slice_in_dim(q, t0, Q_BLOCK, axis=1)
        tpos = t0 + jnp.arange(Q_BLOCK)
        sc = jnp.einsum('bqghd,bcgd->bghqc', qblk, kc).astype(jnp.float32) * scale
        dist_c = tpos[:, None] - c_end[None, :]
        pc = masked_softmax(sc + rel_bias_dense(dist_c, rel_table), dist_c >= 0)
        o_c = jnp.einsum('bghqc,bcgd->bqghd', pc.astype(vc.dtype), vc)
        imp = jnp.einsum('bghqc,cn->bgqn', pc, overlap)
        cur = tpos // SLC_BLOCK
        valid = s_start[None, :] <= tpos[:, None]
        forced = ((blk_ids[None, :] == 0) | (blk_ids[None, :] == cur[:, None])
                  | (blk_ids[None, :] == cur[:, None] - 1))
        score = jnp.where(valid, jnp.where(forced, FORCED_SCORE, imp), -1.0)
        _, idx = lax.top_k(score, top_n)
        ksel = ks_blk[b_idx, g_idx, idx].reshape(bsz, NSA_KV_GROUPS, Q_BLOCK, top_n * SLC_BLOCK, HEAD_DIM)
        vsel = vs_blk[b_idx, g_idx, idx].reshape(bsz, NSA_KV_GROUPS, Q_BLOCK, top_n * SLC_BLOCK, HEAD_DIM)
        spos = (idx[..., None] * SLC_BLOCK + jnp.arange(SLC_BLOCK)).reshape(bsz, NSA_KV_GROUPS, Q_BLOCK, -1)
        dist_s = tpos[None, None, :, None] - spos
        bias_s = table_g[t5_bucket(dist_s), g_idx].transpose(0, 1, 4, 2, 3)
        ss = jnp.einsum('bqghd,bgqkd->bghqk', qblk, ksel).astype(jnp.float32) * scale
        ps = masked_softmax(ss + bias_s, (dist_s >= 0)[:, :, None])
        o_s = jnp.einsum('bghqk,bgqkd->bqghd', ps.astype(vsel.dtype), vsel)
        kw = lax.dynamic_slice_in_dim(kw_pad, t0, Q_BLOCK + WINDOW, axis=1)
        vw = lax.dynamic_slice_in_dim(vw_pad, t0, Q_BLOCK + WINDOW, axis=1)
        wpos = t0 - WINDOW + jnp.arange(Q_BLOCK + WINDOW)
        dist_w = tpos[:, None] - wpos[None, :]
        mask_w = (dist_w >= 0) & (dist_w < WINDOW) & (wpos[None, :] >= 0)
        sw = jnp.einsum('bqghd,bkgd->bghqk', qblk, kw).astype(jnp.float32) * scale
        pw = masked_softmax(sw + rel_bias_dense(dist_w, rel_table), mask_w)
        o_w = jnp.einsum('bghqk,bkgd->bqghd', pw.astype(vw.dtype), vw)
        g = lax.dynamic_slice_in_dim(gates, t0, Q_BLOCK, axis=1)
        o = g[..., 0:1] * o_c + g[..., 1:2] * o_s + g[..., 2:3] * o_w
        return o.reshape(bsz, Q_BLOCK, NSA_Q_DIM)

    out = lax.map(query_block, jnp.arange(seq // Q_BLOCK))
    return out.transpose(1, 0, 2, 3).reshape(bsz, seq, NSA_Q_DIM)


def fox_attention(q, k, v, f_logit, f_bias):
    bsz, seq = q.shape[:2]
    scale = HEAD_DIM ** -0.5
    q = q.reshape(bsz, seq, FOX_HEADS, HEAD_DIM)
    k = k.reshape(bsz, seq, FOX_HEADS, HEAD_DIM)
    v = v.reshape(bsz, seq, FOX_HEADS, HEAD_DIM)
    log_f = jax.nn.log_sigmoid(f_logit.astype(jnp.float32) + f_bias.astype(jnp.float32))
    cum = lax.cumsum(log_f, axis=1).transpose(0, 2, 1)
    kpos = jnp.arange(seq)

    def query_block(qb):
        t0 = qb * Q_BLOCK
        qblk = lax.dynamic_slice_in_dim(q, t0, Q_BLOCK, axis=1)
        cq = lax.dynamic_slice_in_dim(cum, t0, Q_BLOCK, axis=2)
        tpos = t0 + jnp.arange(Q_BLOCK)
        logits = (jnp.einsum('bqhd,bkhd->bhqk', qblk, k).astype(jnp.float32) * scale
                  + (cq[..., None] - cum[:, :, None, :]))
        p = masked_softmax(logits, kpos[None, :] <= tpos[:, None])
        o = jnp.einsum('bhqk,bkhd->bqhd', p.astype(v.dtype), v)
        return o.reshape(bsz, Q_BLOCK, FOX_DIM)

    out = lax.map(query_block, jnp.arange(seq // Q_BLOCK))
    return out.transpose(1, 0, 2, 3).reshape(bsz, seq, FOX_DIM)


def setup_inputs(seed: int = 0) -> dict:
    key = jax.random.key(seed)
    ks = jax.random.split(key, 24)
    f32 = jnp.float32

    def w(k, shape, fan_in):
        return jax.random.normal(k, shape, f32) * fan_in ** -0.5

    def gain(k, shape):
        return 1.0 + 0.02 * jax.random.normal(k, shape, f32)

    return {
        "x": jax.random.normal(ks[0], (BATCH, SEQ, D_MODEL), f32),
        "attn_norm_g": gain(ks[1], (DEPTH, D_MODEL)),
        "w_in": w(ks[2], (DEPTH, D_MODEL, D_IN), D_MODEL),
        "cmp_pos_k": 0.1 * jax.random.normal(ks[3], (DEPTH, CMP_BLOCK, HEAD_DIM), f32),
        "cmp_w1_k": w(ks[4], (DEPTH, CMP_BLOCK * HEAD_DIM, HEAD_DIM), CMP_BLOCK * HEAD_DIM),
        "cmp_w2_k": w(ks[5], (DEPTH, HEAD_DIM, HEAD_DIM), HEAD_DIM),
        "cmp_pos_v": 0.1 * jax.random.normal(ks[6], (DEPTH, CMP_BLOCK, HEAD_DIM), f32),
        "cmp_w1_v": w(ks[7], (DEPTH, CMP_BLOCK * HEAD_DIM, HEAD_DIM), CMP_BLOCK * HEAD_DIM),
        "cmp_w2_v": w(ks[8], (DEPTH, HEAD_DIM, HEAD_DIM), HEAD_DIM),
        "rel_bias_table": 0.5 * jax.random.normal(ks[9], (REL_BUCKETS, NSA_HEADS), f32),
        "fox_forget_bias": 3.0 + 0.5 * jax.random.normal(ks[10], (DEPTH, FOX_HEADS), f32),
        "w_branch_nsa": w(ks[11], (DEPTH, NSA_Q_DIM, D_MODEL), NSA_Q_DIM),
        "w_branch_fox": w(ks[12], (DEPTH, FOX_DIM, D_MODEL), FOX_DIM),
        "w_out": w(ks[13], (DEPTH, D_MODEL, D_MODEL), D_MODEL),
        "ffn_norm_g": gain(ks[14], (DEPTH, D_MODEL)),
        "w_up": w(ks[15], (DEPTH, D_MODEL, 2 * D_FF), D_MODEL),
        "conv_w": w(ks[16], (DEPTH, CONV_WIDTH, D_FF), CONV_WIDTH),
        "conv_b": 0.02 * jax.random.normal(ks[17], (DEPTH, D_FF), f32),
        "w_down": w(ks[18], (DEPTH, D_FF, D_MODEL), D_FF),
        "final_norm_g": gain(ks[19], (D_MODEL,)),
    }


def reference(x, attn_norm_g, w_in, cmp_pos_k, cmp_w1_k, cmp_w2_k, cmp_pos_v, cmp_w1_v, cmp_w2_v,
              rel_bias_table, fox_forget_bias, w_branch_nsa, w_branch_fox, w_out,
              ffn_norm_g, w_up, conv_w, conv_b, w_down, final_norm_g):
    bsz, seq, _ = x.shape
    offsets = np.cumsum(np.array(IN_SPLITS))[:-1].tolist()
    kv_shape = (bsz, seq, NSA_KV_GROUPS, HEAD_DIM)
    for layer in range(DEPTH):
        h = rms_norm(x, attn_norm_g[layer])
        (q_n, kc_n, vc_n, ks_n, vs_n, kw_n, vw_n, g_n,
         q_f, k_f, v_f, f_l, m_a, m_b) = jnp.split(h @ w_in[layer], offsets, axis=-1)
        y_nsa = nsa_attention(q_n, kc_n.reshape(kv_shape), vc_n.reshape(kv_shape),
                              ks_n.reshape(kv_shape), vs_n.reshape(kv_shape),
                              kw_n.reshape(kv_shape), vw_n.reshape(kv_shape), g_n,
                              cmp_pos_k[layer], cmp_w1_k[layer], cmp_w2_k[layer],
                              cmp_pos_v[layer], cmp_w1_v[layer], cmp_w2_v[layer], rel_bias_table)
        y_fox = fox_attention(q_f, k_f, v_f, f_l, fox_forget_bias[layer])
        merged = (jax.nn.sigmoid(m_a) * (y_nsa @ w_branch_nsa[layer])
                  + jax.nn.sigmoid(m_b) * (y_fox @ w_branch_fox[layer]))
        x = x + merged @ w_out[layer]
        h = rms_norm(x, ffn_norm_g[layer])
        u, v = jnp.split(h @ w_up[layer], 2, axis=-1)
        u = causal_dwconv(u, conv_w[layer], conv_b[layer])
        x = x + (jax.nn.gelu(u) * v) @ w_down[layer]
    return rms_norm(x, final_norm_g)
```

```cpp
#include <hip/hip_runtime.h>
#include <hip/hip_cooperative_groups.h>
#include <cstdio>
#include <cstdint>
namespace cg = cooperative_groups;

#define LAS __attribute__((address_space(3)))
typedef unsigned short bf16_t;
typedef short bf16x8 __attribute__((ext_vector_type(8)));
typedef float f32x2 __attribute__((ext_vector_type(2)));
typedef float f32x4 __attribute__((ext_vector_type(4)));
typedef float f32x16 __attribute__((ext_vector_type(16)));
typedef unsigned u32x2 __attribute__((ext_vector_type(2)));
typedef unsigned u32x4 __attribute__((ext_vector_type(4)));

constexpr int NB = 2, S = 16384, DM = 2048, MT = NB * S;
constexpr int NP = 9984;
constexpr int DFF = 5632, NUP = 2 * DFF;
constexpr int C_QN = 0, C_KC = 1024, C_VC = 1280, C_KS = 1536, C_VS = 1792, C_KW = 2048, C_VW = 2304, C_QF = 2560, C_KF = 3584, C_VF = 4608,
              C_MA = 5632, C_MB = 7680, C_SM = 9728;
constexpr float LOG2E = 1.4426950408889634f;
constexpr float QSCALE = 0.08838834764831845f * LOG2E;
constexpr float EPS = 1e-6f;

constexpr size_t MiB = 1u << 20;
constexpr size_t WS_WIN = 1 * MiB, WS_WBN = 40 * MiB, WS_WBF = 44 * MiB, WS_WOUT = 48 * MiB, WS_WUP = 56 * MiB, WS_WDN = 100 * MiB,
                 WS_W1K = 122 * MiB, WS_W1V = 124 * MiB, WS_W2K = 126 * MiB, WS_W2V = 127 * MiB, WS_MISC = 128 * MiB, WS_H = 129 * MiB,
                 WS_PROJ = 257 * MiB, WS_VTF = 881 * MiB, WS_SMALL = 945 * MiB, WS_CUM = 949 * MiB, WS_LSE = 950 * MiB, WS_KC = 951 * MiB,
                 WS_VCT = 952 * MiB, WS_TMPK = 953 * MiB, WS_TMPV = 955 * MiB, WS_END = 961 * MiB;
constexpr size_t WS_UV = WS_PROJ;
constexpr size_t WS_ACT = WS_PROJ, WS_SU = WS_PROJ + 352 * MiB, WS_SV = WS_PROJ + 400 * MiB;
constexpr size_t DO_OW = 0, DO_IMP = 64 * MiB, DO_VTW = 128 * MiB, DO_VTS = 144 * MiB, DO_KCN = 160 * MiB, DO_VCN = 177 * MiB, DO_KSS = 194 * MiB;
constexpr int LDS_BYTES = 147456;
constexpr int ABIAS = 73728, AKT = 17408, AVT = 18432, AV0 = 2 * 17408;
#ifndef PHMASK
#define PHMASK 0xFFFFF
#endif
#define PH(k) if constexpr (((PHMASK) >> (k)) & 1)

__device__ __forceinline__ unsigned cvt_pk_bf16(float lo, float hi) { unsigned r; asm("v_cvt_pk_bf16_f32 %0, %1, %2" : "=v"(r) : "v"(lo), "v"(hi)); return r; }
__device__ __forceinline__ float bflo(unsigned w) { return __uint_as_float(w << 16); }
__device__ __forceinline__ float bfhi(unsigned w) { return __uint_as_float(w & 0xffff0000u); }
__device__ __forceinline__ unsigned pk4_fp8(float a, float b, float c, float d) { int w = 0; w = __builtin_amdgcn_cvt_pk_fp8_f32(a, b, w, false); w = __builtin_amdgcn_cvt_pk_fp8_f32(c, d, w, true); return (unsigned)w; }
__device__ __forceinline__ long mk_i64(unsigned lo, unsigned hi) { return (long)(((unsigned long long)hi << 32) | (unsigned long long)lo); }
__device__ __forceinline__ float fexp2(float x) { return __builtin_amdgcn_exp2f(x); }
__device__ __forceinline__ float frcp(float x) { return __builtin_amdgcn_rcpf(x); }
__device__ __forceinline__ float sigmoidf_(float x) { return frcp(1.0f + fexp2(-x * LOG2E)); }
__device__ __forceinline__ float gelu_tanh(float x) { const float u = 1.5957691216057308f * (x + 0.044715f * x * x * x); return x * frcp(1.0f + fexp2(-u * LOG2E)); }
__device__ __forceinline__ int lane_id() { int r; asm volatile("v_mbcnt_lo_u32_b32 %0, -1, 0\n\tv_mbcnt_hi_u32_b32 %0, -1, %0" : "=v"(r)); return r; }
__device__ __forceinline__ float xh_max(float m) { auto r = __builtin_amdgcn_permlane32_swap(__float_as_uint(m), __float_as_uint(m), false, false); return fmaxf(__uint_as_float(r[0]), __uint_as_float(r[1])); }
__device__ __forceinline__ float xh_sum(float m) { auto r = __builtin_amdgcn_permlane32_swap(__float_as_uint(m), __float_as_uint(m), false, false); return __uint_as_float(r[0]) + __uint_as_float(r[1]); }
__device__ __forceinline__ float xh_partner(float m, int hi) { auto r = __builtin_amdgcn_permlane32_swap(__float_as_uint(m), __float_as_uint(m), false, false); return hi ? __uint_as_float(r[0]) : __uint_as_float(r[1]); }
__device__ __forceinline__ float xr_max(float m) { auto r = __builtin_amdgcn_permlane16_swap(__float_as_uint(m), __float_as_uint(m), false, false); return fmaxf(__uint_as_float(r[0]), __uint_as_float(r[1])); }
__device__ __forceinline__ float xr_sum(float m) { auto r = __builtin_amdgcn_permlane16_swap(__float_as_uint(m), __float_as_uint(m), false, false); return __uint_as_float(r[0]) + __uint_as_float(r[1]); }
__device__ __forceinline__ float wave_sum(float v) {
#pragma unroll
    for (int o = 1; o < 64; o <<= 1) v += __shfl_xor(v, o);
    return v;
}
__device__ __forceinline__ float wave_max(float v) {
#pragma unroll
    for (int o = 1; o < 64; o <<= 1) v = fmaxf(v, __shfl_xor(v, o));
    return v;
}

__device__ __forceinline__ void grid_bar(unsigned* cnt, unsigned G, int wid) {
    asm volatile("s_waitcnt vmcnt(0)" ::: "memory");
    __syncthreads();
    if (wid == 0 && lane_id() == 0) {
        __builtin_amdgcn_fence(__ATOMIC_RELEASE, "agent");
        asm volatile("s_waitcnt vmcnt(0)" ::: "memory");
        __hip_atomic_fetch_add(cnt, 1u, __ATOMIC_RELAXED, __HIP_MEMORY_SCOPE_AGENT);
        while (__hip_atomic_load(cnt, __ATOMIC_RELAXED, __HIP_MEMORY_SCOPE_AGENT) < G) __builtin_amdgcn_s_sleep(1);
        __builtin_amdgcn_fence(__ATOMIC_ACQUIRE, "agent");
        asm volatile("s_waitcnt vmcnt(0)" ::: "memory");
    }
    __syncthreads();
}

namespace pg8 {
constexpr int BM = 256, BK = 64, HALF = 128, HTB = HALF * BK * 2, STAGE_BYTES = 8 * HTB, NXCD = 8, WGM = 8;
__host__ __device__ __forceinline__ int lds_byte(int r, int c) { const int st = (r >> 4) * 2 + (c >> 5), rr = r & 15, cc = c & 31, ob = rr * 64 + cc * 2; return st * 1024 + (ob ^ (((ob >> 9) & 1) << 5)); }
__host__ __device__ __forceinline__ void stage_rc(int b, int& R, int& C) { const int st = b / 1024, sb = b % 1024, swz = sb ^ (((sb >> 9) & 1) << 5); R = (st >> 1) * 16 + swz / 64; C = (st & 1) * 32 + (swz % 64) / 2; }
__host__ __device__ __forceinline__ int perm32(int rho) { const int n = rho >> 4, i = rho & 15; return 8 * (i >> 2) + 4 * n + (i & 3); }
struct Unit { int pm, pn; };
struct Gemm { const bf16_t* A; const bf16_t* Bt; int lda, ldb, K; };
struct StaticOrder {
    int nM, nN, nwg, G, c, wgm;
    __device__ void init(int M, int N, int G_, int c_, int wgm_ = WGM) { nM = M / BM; nN = N / BM; nwg = nM * nN; G = G_; c = c_; wgm = wgm_; }
    __device__ bool next(int i, Unit& u) const {
        const long L = (long)i * G + c; if (L >= nwg) return false;
        int wgid = (int)L; { const int q = nwg / NXCD, r = nwg % NXCD, xcd = wgid % NXCD, off = wgid / NXCD; wgid = (xcd < r ? xcd * (q + 1) : r * (q + 1) + (xcd - r) * q) + off; }
        const int nig = wgm * nN, gid = wgid / nig, fm = gid * wgm, gsz = (nM - fm) < wgm ? (nM - fm) : wgm;
        u.pm = fm + ((wgid % nig) % gsz); u.pn = (wgid % nig) / gsz; return true;
    }
};
template <class Epi, class Sched>
__device__ __forceinline__ void gemm_phase(LAS unsigned char* lds, const Gemm g, const Sched& S, const Epi& E, int wid) {
    const int lane = lane_id(), tid = wid * 64 + lane, wr = wid >> 2, wc = wid & 3, fr = lane & 15, fq = lane >> 4;
    const int K = g.K, nt = K / BK;
    unsigned voffA[2], voffB[2];
#pragma unroll
    for (int i = 0; i < 2; ++i) { int R, C; stage_rc(tid * 16 + i * 8192, R, C); const int Rb = Epi::PERM ? ((R & ~31) + perm32(R & 31)) : R;
        voffA[i] = (unsigned)(R * g.lda + C) * 2u; voffB[i] = (unsigned)(Rb * g.ldb + C) * 2u; }
    const size_t kstep = (size_t)(BK * 2);
    const size_t hstepA = (size_t)HALF * g.lda * 2, hstepB = (size_t)HALF * g.ldb * 2;
    const size_t tstepA = 2 * hstepA, tstepB = 2 * hstepB;
    const unsigned ldsw = (unsigned)wid * 1024u;
    const int aoff = lds_byte(wr * 64 + fr, fq * 8), boff = lds_byte(wc * 32 + fr, fq * 8);
#define PG8_SA(b, h) (((b) * 2 + (h)) * HTB)
#define PG8_SB(b, h) ((4 + (b) * 2 + (h)) * HTB)
#define PG8_STAGE(bufoff, gbase, voff) do { _Pragma("unroll") for (int _i = 0; _i < 2; ++_i) \
        __builtin_amdgcn_global_load_lds((const unsigned*)((const char*)(gbase) + (voff)[_i]), (LAS unsigned*)(lds + (bufoff) + ldsw + _i * 8192), 16, 0, 0); } while (0)
#define PG8_LDA(dst, b, h) do { _Pragma("unroll") for (int m = 0; m < 4; ++m) _Pragma("unroll") for (int k = 0; k < 2; ++k) dst[m][k] = *(const LAS bf16x8*)(lds + PG8_SA(b, h) + aoff + m * 2048 + k * 1024); } while (0)
#define PG8_LDB(dst, b, h) do { _Pragma("unroll") for (int n = 0; n < 2; ++n) _Pragma("unroll") for (int k = 0; k < 2; ++k) dst[n][k] = *(const LAS bf16x8*)(lds + PG8_SB(b, h) + boff + n * 2048 + k * 1024); } while (0)
#define PG8_MMA(ai, bj, At, Bt) do { __builtin_amdgcn_s_setprio(1); _Pragma("unroll") for (int m = 0; m < 4; ++m) _Pragma("unroll") for (int n = 0; n < 2; ++n) _Pragma("unroll") for (int k = 0; k < 2; ++k) \
        acc[ai][bj][m][n] = __builtin_amdgcn_mfma_f32_16x16x32_bf16(Bt[n][k], At[m][k], acc[ai][bj][m][n], 0, 0, 0); __builtin_amdgcn_s_setprio(0); } while (0)
#define PG8_WAIT_V(n) asm volatile("s_waitcnt vmcnt(" #n ")" ::: "memory")
#define PG8_WAIT_L(n) asm volatile("s_waitcnt lgkmcnt(" #n ")" ::: "memory")
#define PG8_BAR __builtin_amdgcn_s_barrier()
#define PG8_SCHED __builtin_amdgcn_sched_barrier(0)
    Unit cur, nxt; int ui = 0;
    if (!S.next(0, cur)) return;
    f32x4 acc[2][2][4][2];
#pragma unroll
    for (int a = 0; a < 2; ++a)
#pragma unroll
        for (int b = 0; b < 2; ++b)
#pragma unroll
            for (int m = 0; m < 4; ++m)
#pragma unroll
                for (int n = 0; n < 2; ++n) acc[a][b][m][n] = (f32x4){0.f, 0.f, 0.f, 0.f};
    bf16x8 At[4][2], B0[2][2], B1[2][2];
    const char* cA = (const char*)g.A + (size_t)cur.pm * tstepA; const char* cB = (const char*)g.Bt + (size_t)cur.pn * tstepB;
    PG8_STAGE(PG8_SB(0, 0), cB, voffB); PG8_STAGE(PG8_SB(0, 1), cB + hstepB, voffB); PG8_STAGE(PG8_SA(0, 0), cA, voffA); PG8_STAGE(PG8_SA(0, 1), cA + hstepA, voffA);
    if (wr == 1) PG8_BAR;
    PG8_WAIT_V(2); PG8_BAR;
    PG8_STAGE(PG8_SB(1, 0), cB + kstep, voffB); PG8_STAGE(PG8_SA(1, 0), cA + kstep, voffA); PG8_STAGE(PG8_SB(1, 1), cB + hstepB + kstep, voffB);
    PG8_WAIT_V(6); PG8_BAR;
    for (;;) {
        const bool has_next = S.next(ui + 1, nxt);
        const char* nA = has_next ? (const char*)g.A + (size_t)nxt.pm * tstepA : cA; const char* nB = has_next ? (const char*)g.Bt + (size_t)nxt.pn * tstepB : cB;
        for (int t = 0; t < nt; t += 2) {
            const bool last = (t == nt - 2);
            const char* a1 = cA + (size_t)(t + 1) * kstep;
            const char* a2 = last ? nA : cA + (size_t)(t + 2) * kstep; const char* b2 = last ? nB : cB + (size_t)(t + 2) * kstep;
            const char* a3 = a2 + kstep; const char* b3 = b2 + kstep;
            PG8_LDB(B0, 0, 0); PG8_LDB(B1, 0, 1); PG8_SCHED; PG8_LDA(At, 0, 0); PG8_STAGE(PG8_SA(1, 1), a1 + hstepA, voffA);
            PG8_WAIT_V(8); PG8_WAIT_L(0); PG8_BAR; PG8_MMA(0, 0, At, B0); PG8_MMA(0, 1, At, B1); PG8_BAR; PG8_SCHED;
            PG8_LDA(At, 0, 1); PG8_STAGE(PG8_SB(0, 0), b2, voffB); PG8_STAGE(PG8_SB(0, 1), b2 + hstepB, voffB); PG8_STAGE(PG8_SA(0, 0), a2, voffA);
            PG8_WAIT_V(8); PG8_WAIT_L(0); PG8_BAR; PG8_MMA(1, 0, At, B0); PG8_MMA(1, 1, At, B1); PG8_BAR; PG8_SCHED;
            PG8_LDB(B0, 1, 0); PG8_LDB(B1, 1, 1); PG8_SCHED; PG8_LDA(At, 1, 0); PG8_STAGE(PG8_SA(0, 1), a2 + hstepA, voffA);
            PG8_WAIT_V(8); PG8_WAIT_L(0); PG8_BAR; PG8_MMA(0, 0, At, B0); PG8_MMA(0, 1, At, B1); PG8_BAR; PG8_SCHED;
            PG8_LDA(At, 1, 1); PG8_STAGE(PG8_SB(1, 0), b3, voffB); PG8_STAGE(PG8_SB(1, 1), b3 + hstepB, voffB); PG8_STAGE(PG8_SA(1, 0), a3, voffA);
            PG8_WAIT_V(8); PG8_WAIT_L(0); PG8_BAR; PG8_MMA(1, 0, At, B0); PG8_MMA(1, 1, At, B1); PG8_BAR; PG8_SCHED;
        }
        if (wr == 0) PG8_BAR;
        if constexpr (Epi::XCHG) E.fused(acc, cur, wid, wr, wc, fr, fq, lds + STAGE_BYTES); else E(acc, cur, wr, wc, fr, fq);
        if (!has_next) break;
#pragma unroll
        for (int a = 0; a < 2; ++a)
#pragma unroll
            for (int b = 0; b < 2; ++b)
#pragma unroll
                for (int m = 0; m < 4; ++m)
#pragma unroll
                    for (int n = 0; n < 2; ++n) acc[a][b][m][n] = (f32x4){0.f, 0.f, 0.f, 0.f};
        cur = nxt; cA = nA; cB = nB; ++ui;
        if (wr == 1) PG8_BAR;
    }
    PG8_WAIT_V(0);
    PG8_BAR;
#undef PG8_SA
#undef PG8_SB
#undef PG8_STAGE
#undef PG8_LDA
#undef PG8_LDB
#undef PG8_MMA
#undef PG8_WAIT_V
#undef PG8_WAIT_L
#undef PG8_BAR
#undef PG8_SCHED
}

#define EPI_ROWS_BEGIN  _Pragma("unroll") for (int ai = 0; ai < 2; ++ai) _Pragma("unroll") for (int m = 0; m < 4; ++m) { const int row = u.pm * BM + wr * 64 + fr + ai * HALF + m * 16;
#define EPI_ROWS_END }
__device__ __forceinline__ u32x4 pack8(const f32x4 v0, const f32x4 v1) { u32x4 w; w.x = cvt_pk_bf16(v0[0], v0[1]); w.y = cvt_pk_bf16(v0[2], v0[3]); w.z = cvt_pk_bf16(v1[0], v1[1]); w.w = cvt_pk_bf16(v1[2], v1[3]); return w; }

struct EpiInProj { static constexpr bool PERM = true, XCHG = false; bf16_t* proj; float* small;
    __device__ __forceinline__ void operator()(const f32x4 (&acc)[2][2][4][2], const Unit& u, int wr, int wc, int fr, int fq) const {
        if (u.pn < 38) { const int col0 = u.pn * BM + wc * 32 + 8 * fq;
            EPI_ROWS_BEGIN bf16_t* rowp = proj + (size_t)row * NP + col0;
#pragma unroll
                for (int bj = 0; bj < 2; ++bj) *(u32x4*)(rowp + bj * HALF) = pack8(acc[ai][bj][m][0], acc[ai][bj][m][1]);
            EPI_ROWS_END
        } else if (wc == 0) {
            EPI_ROWS_BEGIN float* rp = small + (size_t)row * 32 + 8 * fq; *(f32x4*)rp = acc[ai][0][m][0]; *(f32x4*)(rp + 4) = acc[ai][0][m][1];
            EPI_ROWS_END
        }
    }
};
template <int ACT> struct EpiBf16 { static constexpr bool PERM = true, XCHG = false; bf16_t* O; int ldc; const float* bias;
    __device__ __forceinline__ void operator()(const f32x4 (&acc)[2][2][4][2], const Unit& u, int wr, int wc, int fr, int fq) const {
        const int col0 = u.pn * BM + wc * 32 + 8 * fq;
        f32x4 bv[2][2];
#pragma unroll
        for (int bj = 0; bj < 2; ++bj)
#pragma unroll
            for (int n = 0; n < 2; ++n) bv[bj][n] = ACT ? *(const f32x4*)(bias + col0 + bj * HALF + 4 * n) : (f32x4){0.f, 0.f, 0.f, 0.f};
        EPI_ROWS_BEGIN bf16_t* rowp = O + (size_t)row * ldc + col0;
#pragma unroll
            for (int bj = 0; bj < 2; ++bj) { f32x4 v0 = acc[ai][bj][m][0], v1 = acc[ai][bj][m][1];
                if (ACT) { v0 = v0 + bv[bj][0]; v1 = v1 + bv[bj][1];
#pragma unroll
                    for (int i = 0; i < 4; ++i) { v0[i] = gelu_tanh(v0[i]); v1[i] = gelu_tanh(v1[i]); } }
                *(u32x4*)(rowp + bj * HALF) = pack8(v0, v1); }
        EPI_ROWS_END
    }
};
template <bool TR> struct EpiCmp2 { static constexpr bool PERM = true, XCHG = false; bf16_t* O;
    __device__ __forceinline__ void operator()(const f32x4 (&acc)[2][2][4][2], const Unit& u, int wr, int wc, int fr, int fq) const {
        const int col0 = wc * 32 + 8 * fq;
        EPI_ROWS_BEGIN
            if (!TR) { *(u32x4*)(O + (size_t)row * 128 + col0) = pack8(acc[ai][0][m][0], acc[ai][0][m][1]); }
            else {
#pragma unroll
                for (int n = 0; n < 2; ++n)
#pragma unroll
                    for (int i = 0; i < 4; ++i) { const int d = col0 + 4 * n + i; O[((size_t)(row >> 6) * 128 + d) * 64 + (row & 63)] = (bf16_t)(cvt_pk_bf16(acc[ai][0][m][n][i], 0.f) & 0xffffu); }
            }
        EPI_ROWS_END
    }
};
template <bool SECOND> struct EpiMerge { static constexpr bool PERM = true, XCHG = false; const bf16_t* gate; bf16_t* O;
    __device__ __forceinline__ void operator()(const f32x4 (&acc)[2][2][4][2], const Unit& u, int wr, int wc, int fr, int fq) const {
        const int col0 = u.pn * BM + wc * 32 + 8 * fq;
        EPI_ROWS_BEGIN
#pragma unroll
            for (int bj = 0; bj < 2; ++bj) { const u32x4 gv = *(const u32x4*)(gate + (size_t)row * NP + col0 + bj * HALF);
                f32x4 v0 = acc[ai][bj][m][0], v1 = acc[ai][bj][m][1];
                v0[0] *= sigmoidf_(bflo(gv.x)); v0[1] *= sigmoidf_(bfhi(gv.x)); v0[2] *= sigmoidf_(bflo(gv.y)); v0[3] *= sigmoidf_(bfhi(gv.y));
                v1[0] *= sigmoidf_(bflo(gv.z)); v1[1] *= sigmoidf_(bfhi(gv.z)); v1[2] *= sigmoidf_(bflo(gv.w)); v1[3] *= sigmoidf_(bfhi(gv.w));
                bf16_t* op = O + (size_t)row * DM + col0 + bj * HALF;
                if (SECOND) { const u32x4 ov = *(const u32x4*)op;
                    v0[0] += bflo(ov.x); v0[1] += bfhi(ov.x); v0[2] += bflo(ov.y); v0[3] += bfhi(ov.y); v1[0] += bflo(ov.z); v1[1] += bfhi(ov.z); v1[2] += bflo(ov.w); v1[3] += bfhi(ov.w); }
                *(u32x4*)op = pack8(v0, v1); }
        EPI_ROWS_END
    }
};
struct EpiUpAct { static constexpr bool PERM = true, XCHG = false; bf16_t* act; float* SU; float* SV; const float* conv_w; const float* conv_b;
    __device__ __forceinline__ void operator()(const f32x4 (&acc)[2][2][4][2], const Unit& u, int wr, int wc, int fr, int fq) const {
        const int lane = fq * 16 + fr;
        const int s1a = lane - 1, s1b = lane + 15, s2a = lane - 2, s2b = lane + 14;
#pragma unroll
        for (int n = 0; n < 2; ++n) {
            const int j0 = u.pn * 128 + wc * 32 + 8 * fq + 4 * n;
            const f32x4 w0 = *(const f32x4*)(conv_w + j0), w1 = *(const f32x4*)(conv_w + DFF + j0), w2 = *(const f32x4*)(conv_w + 2 * DFF + j0), cb = *(const f32x4*)(conv_b + j0);
#pragma unroll
            for (int ai = 0; ai < 2; ++ai)
#pragma unroll
                for (int m = 0; m < 4; ++m) {
                    const int row = u.pm * BM + wr * 64 + fr + ai * HALF + m * 16;
                    const int grp = row >> 6;
                    f32x4 o;
#pragma unroll
                    for (int i = 0; i < 4; ++i) {
                        const float uc = acc[ai][0][m][n][i];
                        const float up = (m > 0) ? acc[ai][0][m > 0 ? m - 1 : 0][n][i] : 0.f;
                        const float a1 = __shfl(uc, s1a), b1 = __shfl(up, s1b), a2 = __shfl(uc, s2a), b2 = __shfl(up, s2b);
                        const float p1 = (fr >= 1) ? a1 : b1, p2 = (fr >= 2) ? a2 : b2;
                        const float c = cb[i] + w0[i] * p2 + w1[i] * p1 + w2[i] * uc;
                        o[i] = gelu_tanh(c) * acc[ai][1][m][n][i];
                    }
                    if (m == 0 && fr < 2) {
                        *(f32x4*)(SU + ((size_t)grp * 4 + 2 + fr) * DFF + j0) = acc[ai][0][m][n]; *(f32x4*)(SV + ((size_t)grp * 2 + fr) * DFF + j0) = acc[ai][1][m][n];
                    } else {
                        u32x2 w; w.x = cvt_pk_bf16(o[0], o[1]); w.y = cvt_pk_bf16(o[2], o[3]); *(u32x2*)(act + (size_t)row * DFF + j0) = w;
                    }
                    if (m == 3 && fr >= 14) *(f32x4*)(SU + ((size_t)(grp + 1) * 4 + (fr - 14)) * DFF + j0) = acc[ai][0][m][n];
                }
        }
    }
};
struct EpiResid { static constexpr bool PERM = false, XCHG = false; const float* base; float* out; bool dry;
    __device__ __forceinline__ void operator()(const f32x4 (&acc)[2][2][4][2], const Unit& u, int wr, int wc, int fr, int fq) const {
        const int col0 = u.pn * BM + wc * 32 + 4 * fq;
        EPI_ROWS_BEGIN const size_t off = (size_t)row * DM + col0;
#pragma unroll
            for (int bj = 0; bj < 2; ++bj)
#pragma unroll
                for (int n = 0; n < 2; ++n) { const f32x4 bs = *(const f32x4*)(base + off + bj * HALF + n * 16); if (!dry) *(f32x4*)(out + off + bj * HALF + n * 16) = bs + acc[ai][bj][m][n]; }
        EPI_ROWS_END
    }
};
struct RowStats { unsigned* xbuf; unsigned* cnt; };
__device__ __forceinline__ bool row_rstd_exchange(const f32x4 (&v)[2][2][4][2], const Unit& u, int wid, int wr, int wc, int fr, int fq, LAS unsigned char* lx, const RowStats& st) {
    LAS float* Pp = (LAS float*)lx;
    LAS float* Sp = (LAS float*)(lx + 4096);
    LAS unsigned* flag = (LAS unsigned*)(lx + 4096 + 1024);
#pragma unroll
    for (int ai = 0; ai < 2; ++ai)
#pragma unroll
        for (int m = 0; m < 4; ++m) { float s = 0.f;
#pragma unroll
            for (int bj = 0; bj < 2; ++bj)
#pragma unroll
                for (int n = 0; n < 2; ++n) { const f32x4 x = v[ai][bj][m][n]; s += (x[0] * x[0] + x[1] * x[1]) + (x[2] * x[2] + x[3] * x[3]); }
            s += __shfl_xor(s, 16); s += __shfl_xor(s, 32);
            if (fq == 0) Pp[(ai * HALF + wr * 64 + m * 16 + fr) * 4 + wc] = s; }
    asm volatile("s_waitcnt lgkmcnt(0)" ::: "memory"); __builtin_amdgcn_s_barrier(); asm volatile("" ::: "memory");
    const int lane = fq * 16 + fr; const int row = wid * 32 + (lane & 31);
    if (lane < 32) { const f32x4 p = *(const LAS f32x4*)(Pp + row * 4); const float tot = (p[0] + p[1]) + (p[2] + p[3]);
        __hip_atomic_store(st.xbuf + ((size_t)(u.pm * BM + row)) * 8 + u.pn, __float_as_uint(tot), __ATOMIC_RELAXED, __HIP_MEMORY_SCOPE_AGENT); }
    asm volatile("s_waitcnt vmcnt(0)" ::: "memory");
    if (lane == 0) __hip_atomic_fetch_add(st.cnt + 64 * u.pm, 1u, __ATOMIC_RELAXED, __HIP_MEMORY_SCOPE_AGENT);
    if (wid == 0) {
        bool dead = false; unsigned spins = 0;
        while ((unsigned)__builtin_amdgcn_readfirstlane(__hip_atomic_load(st.cnt + 64 * u.pm, __ATOMIC_RELAXED, __HIP_MEMORY_SCOPE_AGENT)) < 64u) {
            __builtin_amdgcn_s_sleep(2); if (++spins > (1u << 20)) { dead = true; break; } }
        __builtin_amdgcn_fence(__ATOMIC_ACQUIRE, "agent");
        if (lane == 0) flag[0] = dead ? 1u : 0u;
    }
    asm volatile("s_waitcnt vmcnt(0) lgkmcnt(0)" ::: "memory"); __builtin_amdgcn_s_barrier(); asm volatile("" ::: "memory");
    if (lane < 32) { const unsigned* slot = st.xbuf + (size_t)(u.pm * BM + row) * 8; float t = 0.f;
#pragma unroll
        for (int k = 0; k < 8; ++k) t += __uint_as_float(__hip_atomic_load(slot + k, __ATOMIC_RELAXED, __HIP_MEMORY_SCOPE_AGENT));
        Sp[row] = rsqrtf(t * (1.0f / DM) + EPS); }
    asm volatile("s_waitcnt vmcnt(0) lgkmcnt(0)" ::: "memory"); __builtin_amdgcn_s_barrier(); asm volatile("" ::: "memory");
    return flag[0] != 0u;
}
struct EpiOutNorm { static constexpr bool PERM = false, XCHG = true; const float* base; float* out; bf16_t* hn; const float* g; RowStats st;
    __device__ __forceinline__ void fused(f32x4 (&acc)[2][2][4][2], const Unit& u, int wid, int wr, int wc, int fr, int fq, LAS unsigned char* lx) const {
        const int col0 = u.pn * BM + wc * 32 + 4 * fq;
        EPI_ROWS_BEGIN const size_t off = (size_t)row * DM + col0;
#pragma unroll
            for (int bj = 0; bj < 2; ++bj)
#pragma unroll
                for (int n = 0; n < 2; ++n) { acc[ai][bj][m][n] += *(const f32x4*)(base + off + bj * HALF + n * 16); *(f32x4*)(out + off + bj * HALF + n * 16) = acc[ai][bj][m][n]; }
            asm volatile("" ::: "memory");
        EPI_ROWS_END
        const bool bad = row_rstd_exchange(acc, u, wid, wr, wc, fr, fq, lx, st);
        const float qn = __builtin_nanf(""); const LAS float* Sp = (const LAS float*)(lx + 4096);
        EPI_ROWS_BEGIN const size_t off = (size_t)row * DM + col0; const float r = bad ? qn : Sp[ai * HALF + wr * 64 + m * 16 + fr];
#pragma unroll
            for (int bj = 0; bj < 2; ++bj)
#pragma unroll
                for (int n = 0; n < 2; ++n) { const f32x4 x = acc[ai][bj][m][n], gg = *(const f32x4*)(g + col0 + bj * HALF + n * 16); u32x2 w; w.x = cvt_pk_bf16(x[0] * r * gg[0], x[1] * r * gg[1]); w.y = cvt_pk_bf16(x[2] * r * gg[2], x[3] * r * gg[3]);
                    *(u32x2*)(hn + off + bj * HALF + n * 16) = w; }
            asm volatile("" ::: "memory");
        EPI_ROWS_END
    }
};
struct EpiFinalNorm { static constexpr bool PERM = false, XCHG = true; float* out; const float* g; RowStats st;
    __device__ __forceinline__ void fused(f32x4 (&acc)[2][2][4][2], const Unit& u, int wid, int wr, int wc, int fr, int fq, LAS unsigned char* lx) const {
        const int col0 = u.pn * BM + wc * 32 + 4 * fq;
        EPI_ROWS_BEGIN const size_t off = (size_t)row * DM + col0;
#pragma unroll
            for (int bj = 0; bj < 2; ++bj)
#pragma unroll
                for (int n = 0; n < 2; ++n) acc[ai][bj][m][n] += *(const f32x4*)(out + off + bj * HALF + n * 16);
            asm volatile("" : "+v"(acc[ai][0][m][0]), "+v"(acc[ai][0][m][1]), "+v"(acc[ai][1][m][0]), "+v"(acc[ai][1][m][1]) :: "memory");
        EPI_ROWS_END
        const bool bad = row_rstd_exchange(acc, u, wid, wr, wc, fr, fq, lx, st);
        const float qn = __builtin_nanf(""); const LAS float* Sp = (const LAS float*)(lx + 4096);
        EPI_ROWS_BEGIN const size_t off = (size_t)row * DM + col0; const float r = bad ? qn : Sp[ai * HALF + wr * 64 + m * 16 + fr];
#pragma unroll
            for (int bj = 0; bj < 2; ++bj)
#pragma unroll
                for (int n = 0; n < 2; ++n) *(f32x4*)(out + off + bj * HALF + n * 16) = acc[ai][bj][m][n] * r * *(const f32x4*)(g + col0 + bj * HALF + n * 16);
            asm volatile("" ::: "memory");
        EPI_ROWS_END
    }
};
}

struct Args {
    const float* x; const float* attn_g; const float* w_in; const float* pos_k; const float* w1_k; const float* w2_k; const float* pos_v; const float* w1_v; const float* w2_v;
    const float* rel; const float* fbias; const float* w_bn; const float* w_bf; const float* w_out; const float* ffn_g; const float* w_up; const float* conv_w; const float* conv_b;
    const float* w_down; const float* final_g;
    float* out; unsigned char* ws; int probe; int pad;
};

template <class F>
__device__ __forceinline__ void transpose_item(const float* W, int ldw, int Ksrc, bf16_t* WT, int ldt, int k0, int n0, F colmap, LAS float* scr, int lane) {
    const int n4 = (lane & 7) * 4; float sc; const int col = colmap(n0 + n4, sc);
    f32x4 v[8];
#pragma unroll
    for (int i = 0; i < 8; ++i) { const int kk = (lane >> 3) + 8 * i; v[i] = (f32x4){0.f, 0.f, 0.f, 0.f}; if (col >= 0 && (k0 + kk) < Ksrc) v[i] = *(const f32x4*)(W + (size_t)(k0 + kk) * ldw + col); }
#pragma unroll
    for (int i = 0; i < 8; ++i) { const int kk = (lane >> 3) + 8 * i; LAS float* d = scr + kk * 33 + n4; d[0] = v[i].x * sc; d[1] = v[i].y * sc; d[2] = v[i].z * sc; d[3] = v[i].w * sc; }
    asm volatile("s_waitcnt lgkmcnt(0)" ::: "memory");
    const int c = lane & 7;
#pragma unroll
    for (int j = 0; j < 4; ++j) { const int nn = (lane >> 3) + 8 * j; const LAS float* s = scr + (8 * c) * 33 + nn;
        u32x4 o; o.x = cvt_pk_bf16(s[0 * 33], s[1 * 33]); o.y = cvt_pk_bf16(s[2 * 33], s[3 * 33]); o.z = cvt_pk_bf16(s[4 * 33], s[5 * 33]); o.w = cvt_pk_bf16(s[6 * 33], s[7 * 33]);
        *(u32x4*)(WT + (size_t)(n0 + nn) * ldt + k0 + 8 * c) = o; }
    asm volatile("s_waitcnt lgkmcnt(0)" ::: "memory");
}
struct MapIn { __device__ __forceinline__ int operator()(int n, float& sc) const {
    sc = (n < 1024 || (n >= C_QF && n < C_KF)) ? QSCALE : 1.0f;
    if (n < 2560) return n; if (n < 5632) return n + 24; if (n < 9728) return n + 32; if (n < 9752) return 2560 + (n - 9728); if (n < 9760) return 5656 + (n - 9752); return -1; } };
struct MapUp { __device__ __forceinline__ int operator()(int n, float& sc) const { sc = 1.0f; const int pn = n >> 8, c = n & 255; return ((c >> 7) ? DFF : 0) + pn * 128 + (c & 127); } };
struct MapId { int N; __device__ __forceinline__ int operator()(int n, float& sc) const { sc = 1.0f; return n < N ? n : -1; } };

__device__ __forceinline__ void rms_row_bf16(const float* xrow, const float* g, bf16_t* orow, int lane) {
    f32x4 v[8]; float s = 0.f;
#pragma unroll
    for (int j = 0; j < 8; ++j) { v[j] = *((const f32x4*)xrow + lane + 64 * j); s += (v[j].x * v[j].x + v[j].y * v[j].y) + (v[j].z * v[j].z + v[j].w * v[j].w); }
    const float rstd = rsqrtf(wave_sum(s) * (1.f / DM) + EPS);
#pragma unroll
    for (int j = 0; j < 8; ++j) { const f32x4 gg = *((const f32x4*)g + lane + 64 * j); u32x2 o; o.x = cvt_pk_bf16(v[j].x * rstd * gg.x, v[j].y * rstd * gg.y); o.y = cvt_pk_bf16(v[j].z * rstd * gg.z, v[j].w * rstd * gg.w);
        *((u32x2*)orow + lane + 64 * j) = o; }
}
__device__ __forceinline__ void rms_row_f32_inplace(float* xrow, const float* g, int lane) {
    f32x4 v[8]; float s = 0.f;
#pragma unroll
    for (int j = 0; j < 8; ++j) { v[j] = *((const f32x4*)xrow + lane + 64 * j); s += (v[j].x * v[j].x + v[j].y * v[j].y) + (v[j].z * v[j].z + v[j].w * v[j].w); }
    const float rstd = rsqrtf(wave_sum(s) * (1.f / DM) + EPS);
#pragma unroll
    for (int j = 0; j < 8; ++j) { const f32x4 gg = *((const f32x4*)g + lane + 64 * j); f32x4 o; o.x = v[j].x * rstd * gg.x; o.y = v[j].y * rstd * gg.y; o.z = v[j].z * rstd * gg.z; o.w = v[j].w * rstd * gg.w;
        *((f32x4*)xrow + lane + 64 * j) = o; }
}

__device__ __forceinline__ int kappa32(int r) { return (r & 0x13) | ((r & 4) << 1) | ((r & 8) >> 1); }
#define MFMA32(a, b, c) __builtin_amdgcn_mfma_f32_32x32x16_bf16((a), (b), (c), 0, 0, 0)
#define MFMA16(a, b, c) __builtin_amdgcn_mfma_f32_16x16x32_bf16((a), (b), (c), 0, 0, 0)

struct AttnP { bf16_t* proj; const bf16_t* kc; const bf16_t* vtf; const bf16_t* vtw; const bf16_t* vct; const float* cum2; const float* lut2; const float* small; bf16_t* ow; float* lse; const float* kmax2; };

template <int MODE>
__device__ __forceinline__ void attn_unit(LAS unsigned char* lds, const AttnP& P, int b, int head_, int qb, int wid, bool dry = false) {
    const int lane = lane_id(), tid = wid * 64 + lane, r32 = lane & 31, hi = lane >> 5;
    const int head = (MODE == 1) ? head_ * 4 + (wid >> 1) : head_;
    const int hl = (MODE == 1) ? (wid >> 1) : 0;
    const int g = head >> 2;
    const int t0 = (MODE == 1) ? qb * 64 : qb * 256, qw0 = (MODE == 1) ? t0 + (wid & 1) * 32 : t0 + wid * 32, t = qw0 + r32;
    const size_t gt = (size_t)b * S + t;
    bf16x8 qf[8];
    { const bf16_t* qp = P.proj + gt * NP + (MODE == 0 ? C_QF : C_QN) + head * 128 + hi * 8;
#pragma unroll
      for (int ks = 0; ks < 8; ++ks) qf[ks] = *(const bf16x8*)(qp + ks * 16); }
    const bf16_t* kbase; size_t kstride; const bf16_t* vbase; int kt0, kt1;
    if (MODE == 0) { kbase = P.proj + (size_t)b * S * NP + C_KF + head * 128; kstride = NP; vbase = P.vtf + (size_t)(b * 8 + head) * 256 * 8192; kt0 = 0; kt1 = (t0 + 256) / 64; }
    else if (MODE == 1) { kbase = P.proj + (size_t)b * S * NP + C_KW + g * 128; kstride = NP; vbase = P.vtw + (size_t)(b * 2 + g) * 256 * 8192; kt0 = (t0 >= 512) ? (t0 - 512) / 64 : 0; kt1 = t0 / 64 + 1; }
    else { kbase = P.kc + (size_t)(b * 2 + g) * 1024 * 128; kstride = 128; vbase = P.vct + (size_t)(b * 2 + g) * 16 * 8192; kt0 = 0; kt1 = (t0 / 16 + 14) / 64 + 1; }
    LAS float* lutl = (LAS float*)(lds + ABIAS) + hl * 512;
    if (MODE == 2) lutl[tid] = P.lut2[head * 512 + tid];
    if (MODE == 1) {
#pragma unroll
        for (int i = 0; i < 4; ++i) ((LAS float*)(lds + ABIAS))[tid + 512 * i] = P.lut2[(g * 4) * 512 + tid + 512 * i]; }
    const float* cump = P.cum2 + (size_t)(b * 8 + head) * S;

    u32x4 kreg[2], vreg[2]; float ckreg = 0.f;
#define AT_LOAD(kt) do { _Pragma("unroll") for (int p = 0; p < 2; ++p) { const int ci = tid + 512 * p; \
        kreg[p] = *(const u32x4*)(kbase + (size_t)((kt) * 64 + (ci >> 4)) * kstride + (ci & 15) * 8); \
        vreg[p] = *(const u32x4*)(vbase + (size_t)(kt) * 8192 + (ci >> 3) * 64 + (ci & 7) * 8); } \
        if (MODE == 0 && tid < 64) ckreg = cump[(kt) * 64 + tid]; } while (0)
#define AT_STORE(buf) do { _Pragma("unroll") for (int p = 0; p < 2; ++p) { const int ci = tid + 512 * p; const int key = ci >> 4, c = ci & 15, d = ci >> 3, c2 = ci & 7; \
        *(LAS u32x4*)(lds + (buf) * AKT + key * 272 + c * 16) = kreg[p]; \
        *(LAS u32x4*)(lds + AV0 + (buf) * AVT + d * 144 + c2 * 16) = vreg[p]; } \
        if (MODE == 0 && tid < 64) lutl[(buf) * 64 + tid] = -ckreg; } while (0)

    float m_run = -1e30f, l_run = 0.f;
    f32x16 O[4];
#pragma unroll
    for (int dt = 0; dt < 4; ++dt)
#pragma unroll
        for (int i = 0; i < 16; ++i) O[dt][i] = 0.f;
    float qkb = 0.f;
    if (MODE == 0) { float ss = 0.f;
#pragma unroll
        for (int ks = 0; ks < 8; ++ks) { const u32x4 w = __builtin_bit_cast(u32x4, qf[ks]);
            ss += bflo(w.x) * bflo(w.x) + bfhi(w.x) * bfhi(w.x) + bflo(w.y) * bflo(w.y) + bfhi(w.y) * bfhi(w.y) + bflo(w.z) * bflo(w.z) + bfhi(w.z) * bfhi(w.z) + bflo(w.w) * bflo(w.w) + bfhi(w.w) * bfhi(w.w); }
        ss += __shfl_xor(ss, 32);
        qkb = sqrtf(ss) * sqrtf(P.kmax2[b * 8 + head]) * 1.001f; }
    LAS unsigned* xflag = (LAS unsigned*)(lds + ABIAS + 1024);
    AT_LOAD(kt1 - 1); AT_STORE(0); __syncthreads();
    const int kr0 = kappa32(r32);
    for (int kt = kt1 - 1; kt >= kt0; --kt) {
        const int buf = (kt1 - 1 - kt) & 1;
        if (kt > kt0) AT_LOAD(kt - 1);
        const int k0 = kt * 64;
        bool inval, needmask;
        if (MODE == 0) { inval = k0 > qw0 + 31; needmask = k0 + 63 > qw0; }
        else if (MODE == 1) { inval = (k0 > qw0 + 31) || (k0 + 63 < qw0 - 511); needmask = (k0 + 63 > qw0) || (k0 < qw0 + 31 - 511); }
        else { inval = 16 * k0 + 31 > qw0 + 31; needmask = 16 * (k0 + 63) + 31 > qw0; }
        bool farc = false;
        if (MODE == 1) farc = !needmask && (qw0 - (k0 + 63) >= 127);
        if (MODE == 2) farc = !needmask && (qw0 - 16 * (k0 + 63) - 31 >= 127);
        if (!inval) {
#pragma unroll
          for (int sub = 0; sub < 2; ++sub) {
            const LAS unsigned char* kb = lds + buf * AKT + (kr0 + 32 * sub) * 272 + hi * 16;
            f32x16 s0;
#pragma unroll
            for (int i = 0; i < 16; ++i) { if (MODE == 0) { const int kl = 32 * sub + 16 * (i >> 3) + 8 * hi + (i & 7); s0[i] = lutl[buf * 64 + kl]; } else s0[i] = 0.f; }
#pragma unroll
            for (int ks = 0; ks < 8; ++ks) { const bf16x8 ka = *(const LAS bf16x8*)(kb + ks * 32); s0 = MFMA32(ka, qf[ks], s0); }
            __builtin_amdgcn_sched_barrier(0);
            float mx = -1e30f;
            if (MODE != 0 && farc) {
                const float c31 = lutl[511];
#pragma unroll
                for (int i = 0; i < 16; ++i) { s0[i] += c31; mx = fmaxf(mx, s0[i]); }
            } else
#pragma unroll
            for (int i = 0; i < 16; ++i) {
                const int kl = 32 * sub + 16 * (i >> 3) + 8 * hi + (i & 7);
                float b0 = 0.f; bool v0 = true;
                if (MODE == 0) { if (needmask) v0 = (k0 + kl) <= t; }
                else { int d0;
                    if (MODE == 1) { d0 = t - (k0 + kl); v0 = (d0 >= 0) && (d0 < 512); }
                    else { d0 = t - 16 * (k0 + kl) - 31; v0 = d0 >= 0; }
                    b0 = lutl[min(max(d0, 0), 511)]; }
                float a0 = s0[i] + b0;
                if (needmask) a0 = v0 ? a0 : -1e30f;
                s0[i] = a0; mx = fmaxf(mx, a0);
            }
            mx = xh_max(mx);
            if (__any(mx > m_run)) {
                const float m_new = fmaxf(m_run, mx); const float alpha = fexp2(m_run - m_new); m_run = m_new; l_run *= alpha;
#pragma unroll
                for (int dt = 0; dt < 4; ++dt)
#pragma unroll
                    for (int i = 0; i < 16; ++i) O[dt][i] *= alpha;
            }
            float ls = 0.f;
#pragma unroll
            for (int i = 0; i < 16; ++i) { float p0 = fexp2(s0[i] - m_run);
                if (needmask) p0 = s0[i] > -1e29f ? p0 : 0.f;
                s0[i] = p0; ls += p0; }
            l_run += ls;
            bf16x8 pb[2];
            { u32x4 w;
              w.x = cvt_pk_bf16(s0[0], s0[1]); w.y = cvt_pk_bf16(s0[2], s0[3]); w.z = cvt_pk_bf16(s0[4], s0[5]); w.w = cvt_pk_bf16(s0[6], s0[7]); pb[0] = __builtin_bit_cast(bf16x8, w);
              w.x = cvt_pk_bf16(s0[8], s0[9]); w.y = cvt_pk_bf16(s0[10], s0[11]); w.z = cvt_pk_bf16(s0[12], s0[13]); w.w = cvt_pk_bf16(s0[14], s0[15]); pb[1] = __builtin_bit_cast(bf16x8, w); }
            const LAS unsigned char* vb = lds + AV0 + buf * AVT + r32 * 144 + hi * 16 + sub * 64;
            __builtin_amdgcn_sched_barrier(0);
#pragma unroll
            for (int dt = 0; dt < 4; ++dt) {
#pragma unroll
                for (int jj = 0; jj < 2; ++jj) { const bf16x8 vf = *(const LAS bf16x8*)(vb + dt * 32 * 144 + jj * 32);
                    O[dt] = MFMA32(vf, pb[jj], O[dt]); } }
            __builtin_amdgcn_sched_barrier(0);
          }
        }
        if (kt > kt0) AT_STORE(buf ^ 1);
        if (MODE == 0 && kt > kt0) {
            const float ub = qkb - cump[k0 - 1];
            const bool done = __all((ub - m_run) < -40.0f);
            if (lane == 0) xflag[(buf << 3) + wid] = done ? 1u : 0u;
        }
        __syncthreads();
        if (MODE == 0 && kt > kt0) {
            const u32x4 f0 = *(const LAS u32x4*)(xflag + (buf << 3)), f1 = *(const LAS u32x4*)(xflag + (buf << 3) + 4);
            if ((f0.x & f0.y & f0.z & f0.w & f1.x & f1.y & f1.z & f1.w) != 0u) { __syncthreads(); break; }
        }
    }
#undef AT_LOAD
#undef AT_STORE
    const float l_tot = xh_sum(l_run);
    float inv = l_tot > 0.f ? 1.0f / l_tot : 0.f;
    if (MODE == 1) inv *= sigmoidf_(P.small[gt * 32 + head * 3 + 2]);
    if (MODE == 2) inv *= sigmoidf_(P.small[gt * 32 + head * 3 + 0]);
    bf16_t* op = (MODE == 0) ? P.proj + gt * NP + C_QF + head * 128 : (MODE == 1) ? P.ow + gt * 1024 + head * 128 : P.proj + gt * NP + C_VF + head * 128;
    if (dry) return;
#pragma unroll
    for (int dt = 0; dt < 4; ++dt)
#pragma unroll
        for (int ig = 0; ig < 4; ++ig) { u32x2 w; w.x = cvt_pk_bf16(O[dt][4 * ig] * inv, O[dt][4 * ig + 1] * inv); w.y = cvt_pk_bf16(O[dt][4 * ig + 2] * inv, O[dt][4 * ig + 3] * inv);
            *(u32x2*)(op + dt * 32 + 8 * ig + 4 * hi) = w; }
    if (MODE == 2 && hi == 0) P.lse[gt * 8 + head] = l_tot > 0.f ? m_run + log2f(l_tot) : 0.f;
}

__device__ __forceinline__ void imp_unit(LAS unsigned char* lds, const AttnP& P, float* imp, int b, int g, int qb, int half, int wid) {
    const int lane = lane_id(), tid = wid * 64 + lane, r32 = lane & 31, hi = lane >> 5;
    const int t0 = qb * 256, qw0 = t0 + wid * 32, t = qw0 + r32;
    const size_t gt = (size_t)b * S + t;
    const bf16_t* qbase = P.proj + gt * NP + C_QN + (g * 4) * 128 + hi * 8;
    bf16x8 qc[8]; float lsec = P.lse[gt * 8 + g * 4];
#pragma unroll
    for (int ks = 0; ks < 8; ++ks) qc[ks] = *(const bf16x8*)(qbase + ks * 16);
    const bf16_t* kbase = P.kc + (size_t)(b * 2 + g) * 1024 * 128;
    const int kt1 = (t0 / 16 + 14) / 64 + 1;
    LAS float* lutl = (LAS float*)(lds + ABIAS);
#pragma unroll
    for (int i = 0; i < 4; ++i) lutl[tid + 512 * i] = P.lut2[(g * 4) * 512 + tid + 512 * i];
    u32x4 kreg[2];
#define IM_LOAD(kt) do { _Pragma("unroll") for (int p = 0; p < 2; ++p) { const int ci = tid + 512 * p; kreg[p] = *(const u32x4*)(kbase + (size_t)((kt) * 64 + (ci >> 4)) * 128 + (ci & 15) * 8); } } while (0)
#define IM_STORE(buf) do { _Pragma("unroll") for (int p = 0; p < 2; ++p) { const int ci = tid + 512 * p; const int key = ci >> 4, c = ci & 15; \
        *(LAS u32x4*)(lds + (buf) * AKT + key * 272 + c * 16) = kreg[p]; } } while (0)
    const int nh = (kt1 + 1) >> 1;
    const int kfirst = half ? nh : 0, klast = half ? kt1 : nh;
    if (kfirst >= klast) return;
    const int kbeg = half ? nh - 1 : 0;
    IM_LOAD(kbeg); IM_STORE(0); __syncthreads();
    const int kr0 = kappa32(r32);
    float carry = 0.f;
    float* irow = imp + ((size_t)(b * 2 + g) * S + t) * 256;
    for (int kt = kbeg; kt < klast; ++kt) {
        const int buf = (kt - kbeg) & 1;
        if (kt + 1 < klast) IM_LOAD(kt + 1);
        const int c0 = kt * 64;
        const bool farc = (qw0 - 16 * (c0 + 63) - 31) >= 127;
        if (!(16 * c0 > qw0)) {
            const LAS unsigned char* kb = lds + buf * AKT + kr0 * 272 + hi * 16;
            f32x16 ps0, ps1;
#pragma unroll
            for (int i = 0; i < 16; ++i) { ps0[i] = 0.f; ps1[i] = 0.f; }
#pragma unroll 1
            for (int hh = 0; hh < 4; ++hh) {
                f32x16 s0, s1; bf16x8 qf[8]; const float lseh = lsec;
#pragma unroll
                for (int ks = 0; ks < 8; ++ks) qf[ks] = qc[ks];
                { const int hn = (hh + 1) & 3; lsec = P.lse[gt * 8 + g * 4 + hn];
#pragma unroll
                  for (int ks = 0; ks < 8; ++ks) qc[ks] = *(const bf16x8*)(qbase + hn * 128 + ks * 16); }
#pragma unroll
                for (int i = 0; i < 16; ++i) { s0[i] = 0.f; s1[i] = 0.f; }
#pragma unroll
                for (int ks = 0; ks < 8; ++ks) {
                    const bf16x8 ka = *(const LAS bf16x8*)(kb + ks * 32); const bf16x8 kb2 = *(const LAS bf16x8*)(kb + ks * 32 + 32 * 272);
                    s0 = MFMA32(ka, qf[ks], s0); s1 = MFMA32(kb2, qf[ks], s1); }
                __builtin_amdgcn_sched_barrier(0);
                if (farc) { const float cc = lutl[hh * 512 + 511] - lseh;
#pragma unroll
                    for (int i = 0; i < 16; ++i) { ps0[i] += fexp2(s0[i] + cc); ps1[i] += fexp2(s1[i] + cc); }
                } else
#pragma unroll
                for (int i = 0; i < 16; ++i) { const int kl = 16 * (i >> 3) + 8 * hi + (i & 7);
                    const int d0 = t - 16 * (c0 + kl) - 31, d1 = d0 - 512;
                    const float e0 = s0[i] + lutl[hh * 512 + min(max(d0, 0), 511)] - lseh, e1 = s1[i] + lutl[hh * 512 + min(max(d1, 0), 511)] - lseh;
                    ps0[i] += d0 >= 0 ? fexp2(e0) : 0.f; ps1[i] += d1 >= 0 ? fexp2(e1) : 0.f; }
            }
            float plast[2][2];
            plast[0][0] = xh_partner(ps0[7], hi); plast[0][1] = xh_partner(ps0[15], hi); plast[1][0] = xh_partner(ps1[7], hi); plast[1][1] = xh_partner(ps1[15], hi);
#pragma unroll
            for (int s = 0; s < 2; ++s)
#pragma unroll
                for (int r = 0; r < 2; ++r) {
                    float pv[8];
#pragma unroll
                    for (int e = 0; e < 8; ++e) pv[e] = s ? ps1[8 * r + e] : ps0[8 * r + e];
                    const float prev = hi ? plast[s][r] : (r == 1 ? plast[s][0] : (s == 1 ? plast[0][1] : carry));
                    f32x2 o; o.x = (pv[0] + pv[1]) + (pv[2] + pv[3]) + prev; o.y = (pv[4] + pv[5]) + (pv[6] + pv[7]) + pv[3];
                    const int j0 = (c0 + 32 * s + 16 * r + 8 * hi) >> 2;
                    if (kt >= kfirst) *(f32x2*)(irow + j0) = o;
                }
            carry = plast[1][1];
        }
        if (kt + 1 < klast) IM_STORE(buf ^ 1);
        __syncthreads();
    }
#undef IM_LOAD
#undef IM_STORE
}

__device__ __forceinline__ void slc_prefetch(const AttnP& P, const float* imp, int b, int g, int t, int lane, f32x4& sc, u32x4 (&q)[4]) {
    const int col = lane & 15, qd = lane >> 4, head = g * 4 + (col & 3); const size_t gt = (size_t)b * S + t;
    sc = *(const f32x4*)(imp + ((size_t)(b * 2 + g) * S + t) * 256 + 4 * lane);
    const bf16_t* qp = P.proj + gt * NP + C_QN + head * 128 + 32 * qd;
#pragma unroll
    for (int ks = 0; ks < 4; ++ks) q[ks] = *(const u32x4*)(qp + 8 * ks);
}
__device__ __forceinline__ void slc_task(LAS unsigned char* lds, const AttnP& P, const float* imp, const bf16_t* vts, const bf16_t* kss, int b, int g, int t, int lane, const f32x4& sc_in, const u32x4 (&q_in)[4], bool dry = false) {
    const int col = lane & 15, qd = lane >> 4, hh = col & 3, head = g * 4 + hh;
    const size_t gt = (size_t)b * S + t; const int cur = t >> 6;
    const LAS float* lutl = (const LAS float*)(lds + ABIAS) + head * 512;
    f32x4 sc = sc_in;
#pragma unroll
    for (int e = 0; e < 4; ++e) { const int j = 4 * lane + e; sc[e] = (j > cur) ? -1.0f : ((j == 0 || j + 1 >= cur) ? 1e4f : sc[e]); }
    bool sl[4];
    if (cur + 1 <= 16) {
#pragma unroll
        for (int e2 = 0; e2 < 4; ++e2) sl[e2] = (4 * lane + e2) <= cur;
    } else {
        unsigned pref = 0u;
#pragma unroll 1
        for (int bit = 30; bit >= 0; --bit) {
            const float c = __uint_as_float(pref | (1u << bit));
            const int cnt = __popcll(__ballot(sc[0] >= c)) + __popcll(__ballot(sc[1] >= c)) + __popcll(__ballot(sc[2] >= c)) + __popcll(__ballot(sc[3] >= c));
            if (cnt >= 16) pref |= 1u << bit;
            if (cnt == 16) break;
        }
        const float T = __uint_as_float(pref);
        const int cgt = __popcll(__ballot(sc[0] > T)) + __popcll(__ballot(sc[1] > T)) + __popcll(__ballot(sc[2] > T)) + __popcll(__ballot(sc[3] > T));
        const int need = 16 - cgt;
        int rk = 0;
#pragma unroll
        for (int e2 = 0; e2 < 4; ++e2) { const unsigned long long bt = __ballot(sc[e2] == T); rk += (int)__builtin_amdgcn_mbcnt_hi((unsigned)(bt >> 32), __builtin_amdgcn_mbcnt_lo((unsigned)bt, 0u)); }
#pragma unroll
        for (int e2 = 0; e2 < 4; ++e2) { const bool tie = sc[e2] == T; sl[e2] = (sc[e2] > T) || (tie && rk < need); rk += tie ? 1 : 0; }
    }
    const unsigned long long sb0 = __ballot(sl[0]), sb1 = __ballot(sl[1]), sb2 = __ballot(sl[2]), sb3 = __ballot(sl[3]);
    long qv[4];
    {
#pragma unroll
      for (int ks = 0; ks < 4; ++ks) { const u32x4 w = q_in[ks];
          unsigned lo = pk4_fp8(bflo(w.x) * 16.f, bfhi(w.x) * 16.f, bflo(w.y) * 16.f, bfhi(w.y) * 16.f), hi2 = pk4_fp8(bflo(w.z) * 16.f, bfhi(w.z) * 16.f, bflo(w.w) * 16.f, bfhi(w.w) * 16.f);
          if (col >= 4) { lo = 0u; hi2 = 0u; }
          qv[ks] = mk_i64(lo, hi2); } }
    float m_run = -1e30f, l_run = 0.f;
    f32x4 O[8];
#pragma unroll
    for (int dt = 0; dt < 8; ++dt) O[dt] = (f32x4){0.f, 0.f, 0.f, 0.f};
#pragma unroll 1
    for (int e4 = 0; e4 < 4; ++e4) {
      unsigned long long bal = e4 == 0 ? sb0 : e4 == 1 ? sb1 : e4 == 2 ? sb2 : sb3;
      while (bal) {
        const int j = __builtin_amdgcn_readfirstlane(4 * (int)__builtin_ctzll(bal) + e4); bal &= bal - 1;
        const unsigned char* kblk = (const unsigned char*)kss + ((size_t)(b * 2 + g) * 256 + j) * 8192 + lane * 16;
        const unsigned char* vblk = (const unsigned char*)vts + ((size_t)(b * 2 + g) * 256 + j) * 8192 + lane * 16;
        u32x4 kf[4][2], vf[8];
#pragma unroll
        for (int T = 0; T < 4; ++T)
#pragma unroll
            for (int p = 0; p < 2; ++p) kf[T][p] = *(const u32x4*)(kblk + (T * 2 + p) * 1024);
#pragma unroll
        for (int dt = 0; dt < 8; ++dt) vf[dt] = *(const u32x4*)(vblk + dt * 1024);
        f32x4 sT[4];
#pragma unroll
        for (int T = 0; T < 4; ++T) { sT[T] = (f32x4){0.f, 0.f, 0.f, 0.f};
#pragma unroll
            for (int p = 0; p < 2; ++p) { sT[T] = __builtin_amdgcn_mfma_f32_16x16x32_fp8_fp8(mk_i64(kf[T][p].x, kf[T][p].y), qv[2 * p], sT[T], 0, 0, 0);
                                          sT[T] = __builtin_amdgcn_mfma_f32_16x16x32_fp8_fp8(mk_i64(kf[T][p].z, kf[T][p].w), qv[2 * p + 1], sT[T], 0, 0, 0); } }
        float mx = -1e30f;
#pragma unroll
        for (int T = 0; T < 4; ++T)
#pragma unroll
            for (int i = 0; i < 4; ++i) { const int kl = 32 * (T >> 1) + 8 * qd + 4 * (T & 1) + i; const int dist = t - (64 * j + kl);
                float a = sT[T][i] * 0.0625f + lutl[min(max(dist, 0), 511)]; a = dist >= 0 ? a : -1e30f; sT[T][i] = a; mx = fmaxf(mx, a); }
        mx = xr_max(xh_max(mx));
        const float m_new = fmaxf(m_run, mx); const float alpha = fexp2(m_run - m_new); m_run = m_new;
        float ls = 0.f;
#pragma unroll
        for (int T = 0; T < 4; ++T)
#pragma unroll
            for (int i = 0; i < 4; ++i) { float p = fexp2(sT[T][i] - m_new); p = sT[T][i] > -1e29f ? p : 0.f; sT[T][i] = p * 64.f; ls += p; }
        l_run = l_run * alpha + ls;
#pragma unroll
        for (int dt = 0; dt < 8; ++dt) O[dt] = O[dt] * alpha;
        long pb[2];
#pragma unroll
        for (int s = 0; s < 2; ++s) pb[s] = mk_i64(pk4_fp8(sT[2 * s][0], sT[2 * s][1], sT[2 * s][2], sT[2 * s][3]), pk4_fp8(sT[2 * s + 1][0], sT[2 * s + 1][1], sT[2 * s + 1][2], sT[2 * s + 1][3]));
#pragma unroll
        for (int dt = 0; dt < 8; ++dt) { O[dt] = __builtin_amdgcn_mfma_f32_16x16x32_fp8_fp8(mk_i64(vf[dt].x, vf[dt].y), pb[0], O[dt], 0, 0, 0);
                                         O[dt] = __builtin_amdgcn_mfma_f32_16x16x32_fp8_fp8(mk_i64(vf[dt].z, vf[dt].w), pb[1], O[dt], 0, 0, 0); }
      }
    }
    const float l_tot = xr_sum(xh_sum(l_run));
    float inv = l_tot > 0.f ? 0.015625f / l_tot : 0.f;
    inv *= sigmoidf_(P.small[gt * 32 + head * 3 + 1]);
    if (col < 4 && !dry) {
        const bf16_t* ocp = P.proj + gt * NP + C_VF + head * 128 + 4 * qd; const bf16_t* owp = P.ow + gt * 1024 + head * 128 + 4 * qd; bf16_t* yp = P.proj + gt * NP + C_QN + head * 128 + 4 * qd;
#pragma unroll
        for (int dt = 0; dt < 8; ++dt) { const u32x2 a = *(const u32x2*)(ocp + dt * 16), w = *(const u32x2*)(owp + dt * 16);
            u32x2 o; o.x = cvt_pk_bf16(O[dt][0] * inv + bflo(a.x) + bflo(w.x), O[dt][1] * inv + bfhi(a.x) + bfhi(w.x)); o.y = cvt_pk_bf16(O[dt][2] * inv + bflo(a.y) + bflo(w.y), O[dt][3] * inv + bfhi(a.y) + bfhi(w.y));
            *(u32x2*)(yp + dt * 16) = o; }
    }
}

#ifndef REP
#define REP -1
#endif
__device__ __forceinline__ void late_weights(LAS unsigned char* lds, const Args& a, int lane, int wid, int lw, int nlw, bf16_t* w_bn_t, bf16_t* w_bf_t, bf16_t* w_out_t, bf16_t* w_up_t, bf16_t* w_dn_t) {
    LAS float* scr = (LAS float*)(lds + wid * 16384);
    constexpr int I_BN = 16 * 64, I_OUT = 32 * 64, I_UP = 32 * 352, I_DN = 88 * 64;
    constexpr int NITEMS = 2 * I_BN + I_OUT + I_UP + I_DN;
    for (int it = lw; it < NITEMS; it += nlw) {
        int r = it;
        if (r < I_BN) { transpose_item(a.w_bn, 2048, 1024, w_bn_t, 1024, 64 * (r / 64), 32 * (r % 64), MapId{2048}, scr, lane); continue; } r -= I_BN;
        if (r < I_BN) { transpose_item(a.w_bf, 2048, 1024, w_bf_t, 1024, 64 * (r / 64), 32 * (r % 64), MapId{2048}, scr, lane); continue; } r -= I_BN;
        if (r < I_OUT) { transpose_item(a.w_out, 2048, 2048, w_out_t, 2048, 64 * (r / 64), 32 * (r % 64), MapId{2048}, scr, lane); continue; } r -= I_OUT;
        if (r < I_UP) { transpose_item(a.w_up, NUP, 2048, w_up_t, 2048, 64 * (r / 352), 32 * (r % 352), MapUp{}, scr, lane); continue; } r -= I_UP;
        transpose_item(a.w_down, 2048, DFF, w_dn_t, DFF, 64 * (r / 64), 32 * (r % 64), MapId{2048}, scr, lane);
    }
}
__device__ __forceinline__ void phase0(LAS unsigned char* lds, const Args& a, int wid, int G, int bx, int gw, int NGW,
    bf16_t* w_in_t, bf16_t* w_bn_t, bf16_t* w_bf_t, bf16_t* w_out_t, bf16_t* w_up_t, bf16_t* w_dn_t, bf16_t* w1k_t, bf16_t* w1v_t, bf16_t* w2k_t, bf16_t* w2v_t, float* c1k, float* c1v, float* lut2,
    bf16_t* hbuf, bf16_t* proj, bf16_t* vtf, float* small, float* cum2, bf16_t* vtw, bf16_t* vts, bf16_t* kcn, bf16_t* vcn, bf16_t* kss) {
    const int lane = lane_id(), tid = wid * 64 + lane; (void)tid;
        LAS float* scr = (LAS float*)(lds + wid * 16384);
        constexpr int I_IN = 32 * 312, I_W1 = 64 * 8, I_W2 = 4 * 8;
        constexpr int NITEMS = I_IN + 2 * I_W1 + 2 * I_W2;
        for (int it = gw; it < NITEMS; it += NGW) {
            int r = it;
            if (r < I_IN) { transpose_item(a.w_in, 9760, 2048, w_in_t, 2048, 64 * (r / 312), 32 * (r % 312), MapIn{}, scr, lane); continue; } r -= I_IN;
            if (r < I_W1) { transpose_item(a.w1_k, 128, 4096, w1k_t, 4096, 64 * (r / 8), 32 * (r % 8), MapId{128}, scr, lane); continue; } r -= I_W1;
            if (r < I_W1) { transpose_item(a.w1_v, 128, 4096, w1v_t, 4096, 64 * (r / 8), 32 * (r % 8), MapId{128}, scr, lane); continue; } r -= I_W1;
            if (r < I_W2) { transpose_item(a.w2_k, 128, 128, w2k_t, 256, 64 * (r / 8), 32 * (r % 8), MapId{128}, scr, lane); continue; } r -= I_W2;
            transpose_item(a.w2_v, 128, 128, w2v_t, 256, 64 * (r / 8), 32 * (r % 8), MapId{128}, scr, lane);
        }
        for (int m = gw; m < MT; m += NGW) rms_row_bf16(a.x + (size_t)m * DM, a.attn_g, hbuf + (size_t)m * DM, lane);
        for (int it = gw; it < 512; it += NGW) {
            const int which = it >> 8, n = it & 255; const float* pos = which ? a.pos_v : a.pos_k; const float* w1 = which ? a.w1_v : a.w1_k; float s = 0.f;
            if (n < 128) { float s4[8] = {0.f, 0.f, 0.f, 0.f, 0.f, 0.f, 0.f, 0.f};
#pragma unroll 1
                for (int k = lane; k < 4096; k += 512) {
#pragma unroll
                    for (int e = 0; e < 8; ++e) s4[e] += pos[k + 64 * e] * w1[(size_t)(k + 64 * e) * 128 + n]; }
                s = ((s4[0] + s4[1]) + (s4[2] + s4[3])) + ((s4[4] + s4[5]) + (s4[6] + s4[7])); }
            s = wave_sum(s); if (lane == 0) (which ? c1v : c1k)[n] = s;
        }
        for (int i = gw * 64 + lane; i < 4096; i += NGW * 64) {
            const int head = i >> 9, n = i & 511; int bk;
            if (n < 16) bk = n; else { const int lg = 16 + (int)(logf((float)n / 16.0f) / logf(8.0f) * 16.0f); bk = lg < 31 ? lg : 31; }
            lut2[i] = a.rel[bk * 8 + head] * LOG2E;
        }
    }

__device__ __forceinline__ void phase2(LAS unsigned char* lds, const Args& a, int wid, int G, int bx, int gw, int NGW,
    bf16_t* w_in_t, bf16_t* w_bn_t, bf16_t* w_bf_t, bf16_t* w_out_t, bf16_t* w_up_t, bf16_t* w_dn_t, bf16_t* w1k_t, bf16_t* w1v_t, bf16_t* w2k_t, bf16_t* w2v_t, float* c1k, float* c1v, float* lut2,
    bf16_t* hbuf, bf16_t* proj, bf16_t* vtf, float* small, float* cum2, bf16_t* vtw, bf16_t* vts, bf16_t* kcn, bf16_t* vcn, bf16_t* kss) {
    const int lane = lane_id(), tid = wid * 64 + lane; (void)tid;
        if (bx < 16) {
            const int b = bx >> 3, h = bx & 7; const float fb = a.fbias[h]; float loc[32]; float run = 0.f;
#pragma unroll
            for (int i = 0; i < 32; ++i) { const float xx = small[((size_t)b * S + tid * 32 + i) * 32 + 24 + h] + fb;
                const float ls = xx >= 0.f ? -log1pf(expf(-xx)) : xx - log1pf(expf(xx)); run += ls; loc[i] = run; }
            float inc = run;
#pragma unroll
            for (int o = 1; o < 64; o <<= 1) { const float nb = __shfl_up(inc, o); if (lane >= o) inc += nb; }
            LAS float* wt = (LAS float*)(lds + 140000);
            if (lane == 63) wt[wid] = inc;
            __syncthreads();
            float off = inc - run;
            for (int w = 0; w < wid; ++w) off += wt[w];
#pragma unroll
            for (int i = 0; i < 32; ++i) cum2[(size_t)(b * 8 + h) * S + tid * 32 + i] = (off + loc[i]) * LOG2E;
            __syncthreads();
        }
        if (bx == 16) { bf16_t* padp = ((tid < 256) ? kcn : vcn) + (size_t)4 * S * 128 + (tid & 255) * 8; *(u32x4*)padp = (u32x4){0u, 0u, 0u, 0u}; }
        LAS unsigned char* scr = lds + wid * 17408;
        constexpr int NTR = 4096 + 1024 + 1024 + 1024;
        for (int it = gw; it < NTR; it += NGW) {
            int seq, tile, col0, kind; bf16_t* dst; int b;
            if (it < 4096) { seq = it >> 8; tile = it & 255; b = seq >> 3; col0 = C_VF + (seq & 7) * 128; dst = vtf; kind = 0; }
            else if (it < 5120) { const int r = it - 4096; seq = r >> 8; tile = r & 255; b = seq >> 1; col0 = C_VW + (seq & 1) * 128; dst = vtw; kind = 0; }
            else if (it < 6144) { const int r = it - 5120; seq = r >> 8; tile = r & 255; b = seq >> 1; col0 = C_VS + (seq & 1) * 128; dst = vts; kind = 1; }
            else { const int r = it - 6144; seq = r >> 8; tile = r & 255; b = seq >> 1; col0 = C_KS + (seq & 1) * 128; dst = kss; kind = 2; }
            const bf16_t* src = proj + ((size_t)b * S + tile * 64) * NP + col0;
#pragma unroll
            for (int i = 0; i < 16; ++i) { const int row = 4 * i + (lane >> 4), ch = lane & 15; *(LAS u32x4*)(scr + row * 272 + ch * 16) = *(const u32x4*)(src + (size_t)row * NP + ch * 8); }
            asm volatile("s_waitcnt lgkmcnt(0)" ::: "memory");
            bf16_t* dblk = dst + ((size_t)seq * 256 + tile) * 8192;
            if (kind == 0) {
#pragma unroll 2
                for (int i = 0; i < 16; ++i) { const int oc = i * 64 + lane, d = oc >> 3, tc = oc & 7; const LAS unsigned short* sp = (const LAS unsigned short*)(scr + (8 * tc) * 272 + d * 2);
                    u32x4 o; o.x = (unsigned)sp[0] | ((unsigned)sp[136] << 16); o.y = (unsigned)sp[272] | ((unsigned)sp[408] << 16); o.z = (unsigned)sp[544] | ((unsigned)sp[680] << 16); o.w = (unsigned)sp[816] | ((unsigned)sp[952] << 16);
                    *(u32x4*)(dblk + d * 64 + 8 * tc) = o; }
            } else if (kind == 1) {
                unsigned char* d8 = (unsigned char*)dst + ((size_t)seq * 256 + tile) * 8192;
#pragma unroll 2
                for (int dt = 0; dt < 8; ++dt) { const int qd = lane >> 4, r = lane & 15; const LAS unsigned short* sp = (const LAS unsigned short*)(scr + (8 * qd) * 272 + (16 * dt + r) * 2);
                    float f[16];
#pragma unroll
                    for (int e = 0; e < 8; ++e) { f[e] = __uint_as_float((unsigned)sp[136 * e] << 16); f[8 + e] = __uint_as_float((unsigned)sp[136 * (32 + e)] << 16); }
                    u32x4 o; o.x = pk4_fp8(f[0], f[1], f[2], f[3]); o.y = pk4_fp8(f[4], f[5], f[6], f[7]); o.z = pk4_fp8(f[8], f[9], f[10], f[11]); o.w = pk4_fp8(f[12], f[13], f[14], f[15]);
                    *(u32x4*)(d8 + (dt * 64 + lane) * 16) = o; }
            } else {
                unsigned char* d8 = (unsigned char*)dst + ((size_t)seq * 256 + tile) * 8192;
#pragma unroll 2
                for (int i = 0; i < 8; ++i) { const int T = i >> 1, p = i & 1, kq = lane >> 4, r = lane & 15; const int key = 32 * (T >> 1) + 8 * (r >> 2) + 4 * (T & 1) + (r & 3);
                    const u32x4 lo = *(const LAS u32x4*)(scr + key * 272 + (32 * kq + 16 * p) * 2), hi = *(const LAS u32x4*)(scr + key * 272 + (32 * kq + 16 * p) * 2 + 16);
                    u32x4 o; o.x = pk4_fp8(bflo(lo.x), bfhi(lo.x), bflo(lo.y), bfhi(lo.y)); o.y = pk4_fp8(bflo(lo.z), bfhi(lo.z), bflo(lo.w), bfhi(lo.w));
                    o.z = pk4_fp8(bflo(hi.x), bfhi(hi.x), bflo(hi.y), bfhi(hi.y)); o.w = pk4_fp8(bflo(hi.z), bfhi(hi.z), bflo(hi.w), bfhi(hi.w));
                    *(u32x4*)(d8 + (i * 64 + lane) * 16) = o; }
            }
            asm volatile("s_waitcnt lgkmcnt(0)" ::: "memory");
        }
        {
            const int b = gw & 1, w2 = gw >> 1, NW2 = NGW >> 1; float mxn = 0.f;
            for (int tk = w2; tk < S; tk += NW2) { const bf16_t* kp = proj + ((size_t)b * S + tk) * NP + C_KF + lane * 16; const u32x4 v0 = *(const u32x4*)kp, v1 = *(const u32x4*)(kp + 8);
                float ss = bflo(v0.x) * bflo(v0.x) + bfhi(v0.x) * bfhi(v0.x) + bflo(v0.y) * bflo(v0.y) + bfhi(v0.y) * bfhi(v0.y) + bflo(v0.z) * bflo(v0.z) + bfhi(v0.z) * bfhi(v0.z) + bflo(v0.w) * bflo(v0.w) + bfhi(v0.w) * bfhi(v0.w)
                         + bflo(v1.x) * bflo(v1.x) + bfhi(v1.x) * bfhi(v1.x) + bflo(v1.y) * bflo(v1.y) + bfhi(v1.y) * bfhi(v1.y) + bflo(v1.z) * bflo(v1.z) + bfhi(v1.z) * bfhi(v1.z) + bflo(v1.w) * bflo(v1.w) + bfhi(v1.w) * bfhi(v1.w);
                ss += __shfl_xor(ss, 1); ss += __shfl_xor(ss, 2); ss += __shfl_xor(ss, 4); mxn = fmaxf(mxn, ss); }
            if ((lane & 7) == 0) atomicMax((unsigned*)(a.ws + 12288) + b * 8 + (lane >> 3), __float_as_uint(mxn));
        }
        for (int it0 = gw; it0 < 2 * 4 * (S / 4); it0 += 4 * NGW) {
            u32x4 v[4]; size_t dsto[4]; int wh[4];
#pragma unroll
            for (int e = 0; e < 4; ++e) { const int it = it0 + e * NGW; const int which = it / (4 * (S / 4)), r = it % (4 * (S / 4)), seq = r / (S / 4), t4 = r % (S / 4); const int b = seq >> 1, g = seq & 1;
                const int tok = t4 * 4 + (lane >> 4), ch = lane & 15; wh[e] = which; dsto[e] = ((size_t)seq * S + tok) * 128 + ch * 8;
                v[e] = *(const u32x4*)(proj + ((size_t)b * S + tok) * NP + (which ? C_VC : C_KC) + g * 128 + ch * 8); }
#pragma unroll
            for (int e = 0; e < 4; ++e) *(u32x4*)((wh[e] ? vcn : kcn) + dsto[e]) = v[e];
        }
    }

__global__ void __launch_bounds__(512, 2) fwd_kernel(Args a) {
    extern __shared__ __attribute__((aligned(16))) unsigned char lds_raw[];
    LAS unsigned char* lds = (LAS unsigned char*)lds_raw;
    cg::grid_group grid = cg::this_grid();
    const int wid = __builtin_amdgcn_readfirstlane(threadIdx.x >> 6);
    const int G = gridDim.x, bx = blockIdx.x;
    const int vcu = (G % 8 == 0) ? (bx % 8) * (G / 8) + bx / 8 : bx;
    const int gw = vcu * 8 + wid, NGW = G * 8;
    unsigned char* ws = a.ws; unsigned char* dob = (unsigned char*)a.out;
    bf16_t* w_in_t = (bf16_t*)(ws + WS_WIN); bf16_t* w_bn_t = (bf16_t*)(ws + WS_WBN); bf16_t* w_bf_t = (bf16_t*)(ws + WS_WBF); bf16_t* w_out_t = (bf16_t*)(ws + WS_WOUT);
    bf16_t* w_up_t = (bf16_t*)(ws + WS_WUP); bf16_t* w_dn_t = (bf16_t*)(ws + WS_WDN); bf16_t* w1k_t = (bf16_t*)(ws + WS_W1K); bf16_t* w1v_t = (bf16_t*)(ws + WS_W1V);
    bf16_t* w2k_t = (bf16_t*)(ws + WS_W2K); bf16_t* w2v_t = (bf16_t*)(ws + WS_W2V);
    float* c1k = (float*)(ws + WS_MISC); float* c1v = c1k + 256; float* lut2 = c1k + 1024;
    bf16_t* hbuf = (bf16_t*)(ws + WS_H); bf16_t* proj = (bf16_t*)(ws + WS_PROJ); bf16_t* vtf = (bf16_t*)(ws + WS_VTF);
    float* small = (float*)(ws + WS_SMALL); float* cum2 = (float*)(ws + WS_CUM); float* lse = (float*)(ws + WS_LSE);
    bf16_t* kc = (bf16_t*)(ws + WS_KC); bf16_t* vct = (bf16_t*)(ws + WS_VCT); bf16_t* tmpk = (bf16_t*)(ws + WS_TMPK); bf16_t* tmpv = (bf16_t*)(ws + WS_TMPV);
    bf16_t* uv = (bf16_t*)(ws + WS_UV);
    bf16_t* ow = (bf16_t*)(dob + DO_OW); float* imp = (float*)(dob + DO_IMP); bf16_t* vtw = (bf16_t*)(dob + DO_VTW); bf16_t* vts = (bf16_t*)(dob + DO_VTS);
    bf16_t* kcn = (bf16_t*)(dob + DO_KCN); bf16_t* vcn = (bf16_t*)(dob + DO_VCN); bf16_t* kss = (bf16_t*)(dob + DO_KSS);

    PH(0) { phase0(lds, a, wid, G, bx, gw, NGW, w_in_t, w_bn_t, w_bf_t, w_out_t, w_up_t, w_dn_t, w1k_t, w1v_t, w2k_t, w2v_t, c1k, c1v, lut2, hbuf, proj, vtf, small, cum2, vtw, vts, kcn, vcn, kss); }
#if REP == 0
    { phase0(lds, a, wid, G, bx, gw, NGW, w_in_t, w_bn_t, w_bf_t, w_out_t, w_up_t, w_dn_t, w1k_t, w1v_t, w2k_t, w2v_t, c1k, c1v, lut2, hbuf, proj, vtf, small, cum2, vtw, vts, kcn, vcn, kss); }
#endif
    grid.sync();
#if 0
    grid_bar((unsigned*)ws + 64 * 1, (unsigned)G, wid);
#endif
    PH(1) { pg8::Gemm g{hbuf, w_in_t, DM, DM, DM}; pg8::StaticOrder So; So.init(MT, NP, G, bx); pg8::EpiInProj E{proj, small}; pg8::gemm_phase(lds, g, So, E, wid); }
#if REP == 1
    { pg8::Gemm g{hbuf, w_in_t, DM, DM, DM}; pg8::StaticOrder So; So.init(MT, NP, G, bx); pg8::EpiInProj E{proj, small}; pg8::gemm_phase(lds, g, So, E, wid); }
#endif
    grid_bar((unsigned*)ws + 64 * 2, (unsigned)G, wid);
#if 0
    grid_bar((unsigned*)ws + 64 * 3, (unsigned)G, wid);
#endif
    PH(2) { phase2(lds, a, wid, G, bx, gw, NGW, w_in_t, w_bn_t, w_bf_t, w_out_t, w_up_t, w_dn_t, w1k_t, w1v_t, w2k_t, w2v_t, c1k, c1v, lut2, hbuf, proj, vtf, small, cum2, vtw, vts, kcn, vcn, kss); }
#if REP == 2
    { phase2(lds, a, wid, G, bx, gw, NGW, w_in_t, w_bn_t, w_bf_t, w_out_t, w_up_t, w_dn_t, w1k_t, w1v_t, w2k_t, w2v_t, c1k, c1v, lut2, hbuf, proj, vtf, small, cum2, vtw, vts, kcn, vcn, kss); }
#endif
    grid_bar((unsigned*)ws + 64 * 4, (unsigned)G, wid);
#if 0
    grid_bar((unsigned*)ws + 64 * 5, (unsigned)G, wid);
#endif
    PH(3) {
        pg8::StaticOrder So; So.init(4096, 256, G / 2, bx >> 1);
        if (bx >= 32) late_weights(lds, a, lane_id(), wid, (bx - 32) * 8 + wid, (G - 32) * 8, w_bn_t, w_bf_t, w_out_t, w_up_t, w_dn_t);
        else if ((bx & 1) == 0) { { pg8::Gemm g{kcn, w1k_t, 2048, 4096, 4096}; pg8::EpiBf16<1> E{tmpk, 256, c1k}; pg8::gemm_phase(lds, g, So, E, wid); }
            asm volatile("s_waitcnt vmcnt(0)" ::: "memory"); __syncthreads();
            { pg8::Gemm g{tmpk, w2k_t, 256, 256, 256}; pg8::EpiCmp2<false> E{kc}; pg8::gemm_phase(lds, g, So, E, wid); } }
        else { { pg8::Gemm g{vcn, w1v_t, 2048, 4096, 4096}; pg8::EpiBf16<1> E{tmpv, 256, c1v}; pg8::gemm_phase(lds, g, So, E, wid); }
            asm volatile("s_waitcnt vmcnt(0)" ::: "memory"); __syncthreads();
            { pg8::Gemm g{tmpv, w2v_t, 256, 256, 256}; pg8::EpiCmp2<true> E{vct}; pg8::gemm_phase(lds, g, So, E, wid); } }
    }
#if REP == 3
    {
        pg8::StaticOrder So; So.init(4096, 256, G / 2, bx >> 1);
        if ((bx & 1) == 0) { pg8::Gemm g{kcn, w1k_t, 2048, 4096, 4096}; pg8::EpiBf16<1> E{tmpk, 256, c1k}; pg8::gemm_phase(lds, g, So, E, wid); }
        else { pg8::Gemm g{vcn, w1v_t, 2048, 4096, 4096}; pg8::EpiBf16<1> E{tmpv, 256, c1v}; pg8::gemm_phase(lds, g, So, E, wid); }
    }
#endif
    grid_bar((unsigned*)ws + 64 * 6, (unsigned)G, wid);
#if 0
    grid_bar((unsigned*)ws + 64 * 7, (unsigned)G, wid);
#endif
    const AttnP AP{proj, kc, vtf, vtw, vct, cum2, lut2, small, ow, lse, (const float*)(ws + 12288)};
    PH(5) {
#ifndef ATM
#define ATM 7
#endif
        if (a.probe == 5) for (int q = vcu * 4; q < 1024; q += G * 4)
#pragma unroll 1
            for (int i = 0; i < 4; ++i) { const int pp = (q + i) >> 1; if (pp >= 512) break; const int bh = pp >> 5, s = pp & 31;
                attn_unit<0>(lds, AP, bh >> 3, bh & 7, (i & 1) ? s : 63 - s, wid, true); }
        {
            unsigned* qctr = (unsigned*)(ws + 12544);
            LAS int* qslot = (LAS int*)(lds + ABIAS + 20480);
#pragma unroll 1
            for (;;) {
                if (wid == 0 && lane_id() == 0) *qslot = (int)atomicAdd(qctr, 1u);
                __syncthreads();
                const int q = __builtin_amdgcn_readfirstlane(*qslot);
                __syncthreads();
                if (q >= 3072) break;
                if (q < 1024) { const int bh = q >> 6; attn_unit<0>(lds, AP, bh >> 3, bh & 7, 63 - (q & 63), wid); }
                else if (q < 2048) { const int u = q - 1024, bg = u >> 8; attn_unit<1>(lds, AP, bg >> 1, bg & 1, 255 - (u & 255), wid); }
                else { const int u = q - 2048, bh = u & 15; attn_unit<2>(lds, AP, bh >> 3, bh & 7, 63 - (u >> 4), wid); }
            }
        }
    }
    grid_bar((unsigned*)ws + 64 * 10, (unsigned)G, wid);
#if 0
    grid_bar((unsigned*)ws + 64 * 11, (unsigned)G, wid);
#endif
    PH(6) for (int uu = vcu; uu < 256; uu += G) for (int e2 = 0; e2 < 2; ++e2) { const int u = e2 ? 511 - uu : uu; const int qb = 63 - (u >> 3), rest = u & 7; imp_unit(lds, AP, imp, rest >> 2, (rest >> 1) & 1, qb, rest & 1, wid); }
#if REP == 6
    for (int uu = vcu; uu < 256; uu += G) for (int e2 = 0; e2 < 2; ++e2) { const int u = e2 ? 511 - uu : uu; const int qb = 63 - (u >> 3), rest = u & 7; imp_unit(lds, AP, imp, rest >> 2, (rest >> 1) & 1, qb, rest & 1, wid); }
#endif
    grid_bar((unsigned*)ws + 64 * 12, (unsigned)G, wid);
#if 0
    grid_bar((unsigned*)ws + 64 * 13, (unsigned)G, wid);
#endif
    PH(7) {
        LAS float* lutl = (LAS float*)(lds + ABIAS);
#pragma unroll
        for (int i = 0; i < 8; ++i) { const int tid = wid * 64 + lane_id(); lutl[tid + 512 * i] = lut2[tid + 512 * i]; }
        __syncthreads();
        const int ntask = NB * 2 * S;
        if (G == 256) {
            const int xcd = bx & 7, lb = bx >> 3, bg = xcd >> 1, tb = (xcd & 1) * 8192;
            if (a.probe == 7) for (int r = 0; r < 32; ++r) { f32x4 sc; u32x4 q[4]; const int ln = lane_id(); slc_prefetch(AP, imp, bg >> 1, bg & 1, tb + r * 256 + lb * 8 + wid, ln, sc, q);
                slc_task(lds, AP, imp, vts, kss, bg >> 1, bg & 1, tb + r * 256 + lb * 8 + wid, ln, sc, q, true); }
            { f32x4 sc; u32x4 q[4]; const int ln = lane_id();
              slc_prefetch(AP, imp, bg >> 1, bg & 1, tb + lb * 8 + wid, ln, sc, q);
#pragma unroll 1
              for (int r = 0; r < 32; ++r) { f32x4 scn = sc; u32x4 qn[4] = {q[0], q[1], q[2], q[3]};
                  if (r + 1 < 32) slc_prefetch(AP, imp, bg >> 1, bg & 1, tb + (r + 1) * 256 + lb * 8 + wid, ln, scn, qn);
                  slc_task(lds, AP, imp, vts, kss, bg >> 1, bg & 1, tb + r * 256 + lb * 8 + wid, ln, sc, q);
                  sc = scn; q[0] = qn[0]; q[1] = qn[1]; q[2] = qn[2]; q[3] = qn[3]; } }
        } else {
            for (int task = gw; task < ntask; task += NGW) { const int bg = task / S; f32x4 sc; u32x4 q[4]; const int ln = lane_id(); slc_prefetch(AP, imp, bg >> 1, bg & 1, task % S, ln, sc, q); slc_task(lds, AP, imp, vts, kss, bg >> 1, bg & 1, task % S, ln, sc, q); }
        }
    }
    grid_bar((unsigned*)ws + 64 * 14, (unsigned)G, wid);
#if 0
    grid_bar((unsigned*)ws + 64 * 15, (unsigned)G, wid);
#endif
    PH(8) {
        pg8::StaticOrder So; So.init(MT, DM, G, bx);
        { pg8::Gemm g{proj + C_QN, w_bn_t, NP, 1024, 1024}; pg8::EpiMerge<false> E{proj + C_MA, hbuf}; pg8::gemm_phase(lds, g, So, E, wid); }
        { pg8::Gemm g{proj + C_QF, w_bf_t, NP, 1024, 1024}; pg8::EpiMerge<true> E{proj + C_MB, hbuf}; pg8::gemm_phase(lds, g, So, E, wid); }
    }
#if REP == 8
    {
        pg8::StaticOrder So; So.init(MT, DM, G, bx);
        { pg8::Gemm g{proj + C_QN, w_bn_t, NP, 1024, 1024}; pg8::EpiMerge<false> E{proj + C_MA, hbuf}; pg8::gemm_phase(lds, g, So, E, wid); }
        { pg8::Gemm g{proj + C_QF, w_bf_t, NP, 1024, 1024}; pg8::EpiMerge<true> E{proj + C_MB, hbuf}; pg8::gemm_phase(lds, g, So, E, wid); }
    }
#endif
    grid_bar((unsigned*)ws + 64 * 16, (unsigned)G, wid);
#if 0
    grid_bar((unsigned*)ws + 64 * 17, (unsigned)G, wid);
#endif
#ifndef FUSE9
#define FUSE9 1
#endif
#ifndef FUSE13
#define FUSE13 1
#endif
    constexpr bool fused9 = FUSE9, fused13 = FUSE13;
    PH(9) { pg8::Gemm g{hbuf, w_out_t, DM, DM, DM}; pg8::StaticOrder So;
#if FUSE9
        So.init(MT, DM, G, bx, 4); pg8::EpiOutNorm E{a.x, a.out, hbuf, a.ffn_g, pg8::RowStats{(unsigned*)(ws + 957 * MiB), (unsigned*)(ws + 16384)}}; pg8::gemm_phase(lds, g, So, E, wid); }
#else
        So.init(MT, DM, G, bx); pg8::EpiResid E{a.x, a.out, false}; pg8::gemm_phase(lds, g, So, E, wid); }
#endif
#if REP == 9
    { pg8::Gemm g{hbuf, w_out_t, DM, DM, DM}; pg8::StaticOrder So; So.init(MT, DM, G, bx); pg8::EpiResid E{a.x, a.out, false}; pg8::gemm_phase(lds, g, So, E, wid); }
#endif
    grid_bar((unsigned*)ws + 64 * 18, (unsigned)G, wid);
#if 0
    grid_bar((unsigned*)ws + 64 * 19, (unsigned)G, wid);
#endif
    PH(10) if (!fused9) for (int m = gw; m < MT; m += NGW) rms_row_bf16(a.out + (size_t)m * DM, a.ffn_g, hbuf + (size_t)m * DM, lane_id());
#if REP == 10
    for (int m = gw; m < MT; m += NGW) rms_row_bf16(a.out + (size_t)m * DM, a.ffn_g, hbuf + (size_t)m * DM, lane_id());
#endif
    if (!fused9) grid_bar((unsigned*)ws + 64 * 20, (unsigned)G, wid);
#if 0
    grid_bar((unsigned*)ws + 64 * 21, (unsigned)G, wid);
#endif
    PH(11) { pg8::Gemm g{hbuf, w_up_t, DM, DM, DM}; pg8::StaticOrder So; So.init(MT, NUP, G, bx); pg8::EpiUpAct E{(bf16_t*)(ws + WS_ACT), (float*)(ws + WS_SU), (float*)(ws + WS_SV), a.conv_w, a.conv_b}; pg8::gemm_phase(lds, g, So, E, wid); }
#if REP == 11
    { pg8::Gemm g{hbuf, w_up_t, DM, DM, DM}; pg8::StaticOrder So; So.init(MT, NUP, G, bx); pg8::EpiUpAct E{(bf16_t*)(ws + WS_ACT), (float*)(ws + WS_SU), (float*)(ws + WS_SV), a.conv_w, a.conv_b}; pg8::gemm_phase(lds, g, So, E, wid); }
#endif
    grid_bar((unsigned*)ws + 64 * 22, (unsigned)G, wid);
#if 0
    grid_bar((unsigned*)ws + 64 * 23, (unsigned)G, wid);
#endif
    PH(12) {
        float* SU = (float*)(ws + WS_SU); float* SV = (float*)(ws + WS_SV); bf16_t* actb = (bf16_t*)(ws + WS_ACT);
        constexpr int NCG = DFF / 4;
        for (int it = bx * 512 + wid * 64 + lane_id(); it < 512 * NCG; it += G * 512) {
            const int grp = it / NCG, j0 = (it % NCG) * 4; const bool first = (grp & 255) == 0;
            const f32x4 w0 = *(const f32x4*)(a.conv_w + j0), w1 = *(const f32x4*)(a.conv_w + DFF + j0), w2 = *(const f32x4*)(a.conv_w + 2 * DFF + j0), cb = *(const f32x4*)(a.conv_b + j0);
            const float* su = SU + (size_t)grp * 4 * DFF + j0;
            f32x4 um2 = (f32x4){0.f, 0.f, 0.f, 0.f}, um1 = um2;
            if (!first) { um2 = *(const f32x4*)su; um1 = *(const f32x4*)(su + DFF); }
            const f32x4 u0 = *(const f32x4*)(su + 2 * DFF), u1 = *(const f32x4*)(su + 3 * DFF);
            const f32x4 v0 = *(const f32x4*)(SV + (size_t)grp * 2 * DFF + j0), v1 = *(const f32x4*)(SV + ((size_t)grp * 2 + 1) * DFF + j0);
            f32x4 o0, o1;
#pragma unroll
            for (int i = 0; i < 4; ++i) { o0[i] = gelu_tanh(cb[i] + w0[i] * um2[i] + w1[i] * um1[i] + w2[i] * u0[i]) * v0[i]; o1[i] = gelu_tanh(cb[i] + w0[i] * um1[i] + w1[i] * u0[i] + w2[i] * u1[i]) * v1[i]; }
            u32x2 p0, p1; p0.x = cvt_pk_bf16(o0[0], o0[1]); p0.y = cvt_pk_bf16(o0[2], o0[3]); p1.x = cvt_pk_bf16(o1[0], o1[1]); p1.y = cvt_pk_bf16(o1[2], o1[3]);
            *(u32x2*)(actb + (size_t)(grp * 64) * DFF + j0) = p0; *(u32x2*)(actb + (size_t)(grp * 64 + 1) * DFF + j0) = p1;
        }
    }
    grid_bar((unsigned*)ws + 64 * 24, (unsigned)G, wid);
#if 0
    grid_bar((unsigned*)ws + 64 * 25, (unsigned)G, wid);
#endif
#if REP == 13
    { pg8::Gemm g{(const bf16_t*)(ws + WS_ACT), w_dn_t, DFF, DFF, DFF}; pg8::StaticOrder So; So.init(MT, DM, G, bx); pg8::EpiResid E{a.out, a.out, a.probe == 0}; pg8::gemm_phase(lds, g, So, E, wid); }
#endif
    PH(13) { pg8::Gemm g{(const bf16_t*)(ws + WS_ACT), w_dn_t, DFF, DFF, DFF}; pg8::StaticOrder So;
#if FUSE13
        So.init(MT, DM, G, bx, 4); pg8::EpiFinalNorm E{a.out, a.final_g, pg8::RowStats{(unsigned*)(ws + 958 * MiB), (unsigned*)(ws + 16384 + 32768)}}; pg8::gemm_phase(lds, g, So, E, wid); }
#else
        So.init(MT, DM, G, bx); pg8::EpiResid E{a.out, a.out, false}; pg8::gemm_phase(lds, g, So, E, wid); }
#endif
    if (!fused13) grid_bar((unsigned*)ws + 64 * 26, (unsigned)G, wid);
#if 0
    grid_bar((unsigned*)ws + 64 * 27, (unsigned)G, wid);
#endif
    PH(14) if (!fused13) for (int m = gw; m < MT; m += NGW) rms_row_f32_inplace(a.out + (size_t)m * DM, a.final_g, lane_id());
}

extern "C" void kernel_launch(void* const* d_in, const int* in_sizes, int n_in, void* d_out, int out_size, void* d_ws, size_t ws_size, hipStream_t stream) {
    static int grid = 0;
    if (grid == 0) {
        if (n_in != 20 || out_size != MT * DM || ws_size < WS_END) { fprintf(stderr, "kernel_launch: unexpected shapes (n_in %d out %d ws %zu)\n", n_in, out_size, ws_size); grid = -1; return; }
        int dev = 0, cus = 0, per_cu = 0;
        (void)hipGetDevice(&dev); (void)hipDeviceGetAttribute(&cus, hipDeviceAttributeMultiprocessorCount, dev);
        if (hipFuncSetAttribute((const void*)fwd_kernel, hipFuncAttributeMaxDynamicSharedMemorySize, LDS_BYTES) != hipSuccess) { fprintf(stderr, "kernel_launch: hipFuncSetAttribute failed\n"); grid = -1; return; }
        if (hipOccupancyMaxActiveBlocksPerMultiprocessor(&per_cu, (const void*)fwd_kernel, 512, LDS_BYTES) != hipSuccess || per_cu < 1) { fprintf(stderr, "kernel_launch: occupancy query says %d\n", per_cu); per_cu = 1; }
        (void)hipGetLastError();
        grid = cus * 1;
        if (grid != 256) { fprintf(stderr, "kernel_launch: built for a 256-CU device (fused-norm epilogues pair the 8 owners of a row panel in one round); got %d\n", grid); grid = -1; return; }
        fprintf(stderr, "kernel_launch: grid %d (cus %d, per_cu %d), ws %zu\n", grid, cus, per_cu, ws_size);
    }
    if (grid < 0) return;
    (void)hipMemsetAsync(d_ws, 0, 131072, stream);
    Args a{};
    const float** f = (const float**)&a;
    for (int i = 0; i < 20; ++i) f[i] = (const float*)d_in[i];
    a.out = (float*)d_out; a.ws = (unsigned char*)d_ws;
#ifndef PROBE
#define PROBE 0
#endif
    a.probe = PROBE; a.pad = 0;
    void* args[] = {&a};
    hipError_t e = hipLaunchCooperativeKernel((const void*)fwd_kernel, dim3(grid), dim3(512), args, LDS_BYTES, stream);
    if (e != hipSuccess) fprintf(stderr, "kernel_launch: cooperative launch failed: %s\n", hipGetErrorString(e));
}
```

```cpp
#include <hip/hip_runtime.h>
#include <hip/hip_cooperative_groups.h>
#include <cstdio>
#include <cstdint>
namespace cg = cooperative_groups;

#define LAS __attribute__((address_space(3)))
typedef unsigned short bf16_t;
typedef short bf16x8 __attribute__((ext_vector_type(8)));
typedef float f32x2 __attribute__((ext_vector_type(2)));
typedef float f32x4 __attribute__((ext_vector_type(4)));
typedef float f32x16 __attribute__((ext_vector_type(16)));
typedef unsigned u32x2 __attribute__((ext_vector_type(2)));
typedef unsigned u32x4 __attribute__((ext_vector_type(4)));

constexpr int NB = 2, S = 16384, DM = 2048, MT = NB * S;
constexpr int NP = 9984;
constexpr int DFF = 5632, NUP = 2 * DFF;
constexpr int C_QN = 0, C_KC = 1024, C_VC = 1280, C_KS = 1536, C_VS = 1792, C_KW = 2048, C_VW = 2304, C_QF = 2560, C_KF = 3584, C_VF = 4608,
              C_MA = 5632, C_MB = 7680, C_SM = 9728;
constexpr float LOG2E = 1.4426950408889634f;
constexpr float QSCALE = 0.08838834764831845f * LOG2E;
constexpr float EPS = 1e-6f;

constexpr size_t MiB = 1u << 20;
constexpr size_t WS_WIN = 1 * MiB, WS_WBN = 40 * MiB, WS_WBF = 44 * MiB, WS_WOUT = 48 * MiB, WS_WUP = 56 * MiB, WS_WDN = 100 * MiB,
                 WS_W1K = 122 * MiB, WS_W1V = 124 * MiB, WS_W2K = 126 * MiB, WS_W2V = 127 * MiB, WS_MISC = 128 * MiB, WS_H = 129 * MiB,
                 WS_PROJ = 257 * MiB, WS_VTF = 881 * MiB, WS_SMALL = 945 * MiB, WS_CUM = 949 * MiB, WS_LSE = 950 * MiB, WS_KC = 951 * MiB,
                 WS_VCT = 952 * MiB, WS_TMPK = 953 * MiB, WS_TMPV = 955 * MiB, WS_END = 961 * MiB;
constexpr size_t WS_UV = WS_PROJ;
constexpr size_t WS_ACT = WS_PROJ, WS_SU = WS_PROJ + 352 * MiB, WS_SV = WS_PROJ + 400 * MiB;
constexpr size_t DO_OW = 0, DO_IMP = 64 * MiB, DO_VTW = 128 * MiB, DO_VTS = 144 * MiB, DO_KCN = 160 * MiB, DO_VCN = 177 * MiB, DO_KSS = 194 * MiB;
constexpr int LDS_BYTES = 147456;
constexpr int ABIAS = 73728, AKT = 17408, AVT = 18432, AV0 = 2 * 17408;
#ifndef PHMASK
#define PHMASK 0xFFFFF
#endif
#define PH(k) if constexpr (((PHMASK) >> (k)) & 1)

__device__ __forceinline__ unsigned cvt_pk_bf16(float lo, float hi) { unsigned r; asm("v_cvt_pk_bf16_f32 %0, %1, %2" : "=v"(r) : "v"(lo), "v"(hi)); return r; }
__device__ __forceinline__ float bflo(unsigned w) { return __uint_as_float(w << 16); }
__device__ __forceinline__ float bfhi(unsigned w) { return __uint_as_float(w & 0xffff0000u); }
__device__ __forceinline__ unsigned pk4_fp8(float a, float b, float c, float d) { int w = 0; w = __builtin_amdgcn_cvt_pk_fp8_f32(a, b, w, false); w = __builtin_amdgcn_cvt_pk_fp8_f32(c, d, w, true); return (unsigned)w; }
__device__ __forceinline__ long mk_i64(unsigned lo, unsigned hi) { return (long)(((unsigned long long)hi << 32) | (unsigned long long)lo); }
__device__ __forceinline__ float fexp2(float x) { return __builtin_amdgcn_exp2f(x); }
__device__ __forceinline__ float frcp(float x) { return __builtin_amdgcn_rcpf(x); }
__device__ __forceinline__ float sigmoidf_(float x) { return frcp(1.0f + fexp2(-x * LOG2E)); }
__device__ __forceinline__ float gelu_tanh(float x) { const float u = 1.5957691216057308f * (x + 0.044715f * x * x * x); return x * frcp(1.0f + fexp2(-u * LOG2E)); }
__device__ __forceinline__ int lane_id() { int r; asm volatile("v_mbcnt_lo_u32_b32 %0, -1, 0\n\tv_mbcnt_hi_u32_b32 %0, -1, %0" : "=v"(r)); return r; }
__device__ __forceinline__ float xh_max(float m) { auto r = __builtin_amdgcn_permlane32_swap(__float_as_uint(m), __float_as_uint(m), false, false); return fmaxf(__uint_as_float(r[0]), __uint_as_float(r[1])); }
__device__ __forceinline__ float xh_sum(float m) { auto r = __builtin_amdgcn_permlane32_swap(__float_as_uint(m), __float_as_uint(m), false, false); return __uint_as_float(r[0]) + __uint_as_float(r[1]); }
__device__ __forceinline__ float xh_partner(float m, int hi) { auto r = __builtin_amdgcn_permlane32_swap(__float_as_uint(m), __float_as_uint(m), false, false); return hi ? __uint_as_float(r[0]) : __uint_as_float(r[1]); }
__device__ __forceinline__ float xr_max(float m) { auto r = __builtin_amdgcn_permlane16_swap(__float_as_uint(m), __float_as_uint(m), false, false); return fmaxf(__uint_as_float(r[0]), __uint_as_float(r[1])); }
__device__ __forceinline__ float xr_sum(float m) { auto r = __builtin_amdgcn_permlane16_swap(__float_as_uint(m), __float_as_uint(m), false, false); return __uint_as_float(r[0]) + __uint_as_float(r[1]); }
__device__ __forceinline__ float wave_sum(float v) {
#pragma unroll
    for (int o = 1; o < 64; o <<= 1) v += __shfl_xor(v, o);
    return v;
}
__device__ __forceinline__ float wave_max(float v) {
#pragma unroll
    for (int o = 1; o < 64; o <<= 1) v = fmaxf(v, __shfl_xor(v, o));
    return v;
}

__device__ __forceinline__ void grid_bar(unsigned* cnt, unsigned G, int wid) {
    asm volatile("s_waitcnt vmcnt(0)" ::: "memory");
    __syncthreads();
    if (wid == 0 && lane_id() == 0) {
        __builtin_amdgcn_fence(__ATOMIC_RELEASE, "agent");
        asm volatile("s_waitcnt vmcnt(0)" ::: "memory");
        __hip_atomic_fetch_add(cnt, 1u, __ATOMIC_RELAXED, __HIP_MEMORY_SCOPE_AGENT);
        while (__hip_atomic_load(cnt, __ATOMIC_RELAXED, __HIP_MEMORY_SCOPE_AGENT) < G) __builtin_amdgcn_s_sleep(1);
        __builtin_amdgcn_fence(__ATOMIC_ACQUIRE, "agent");
        asm volatile("s_waitcnt vmcnt(0)" ::: "memory");
    }
    __syncthreads();
}

namespace pg8 {
constexpr int BM = 256, BK = 64, HALF = 128, HTB = HALF * BK * 2, STAGE_BYTES = 8 * HTB, NXCD = 8, WGM = 8;
__host__ __device__ __forceinline__ int lds_byte(int r, int c) { const int st = (r >> 4) * 2 + (c >> 5), rr = r & 15, cc = c & 31, ob = rr * 64 + cc * 2; return st * 1024 + (ob ^ (((ob >> 9) & 1) << 5)); }
__host__ __device__ __forceinline__ void stage_rc(int b, int& R, int& C) { const int st = b / 1024, sb = b % 1024, swz = sb ^ (((sb >> 9) & 1) << 5); R = (st >> 1) * 16 + swz / 64; C = (st & 1) * 32 + (swz % 64) / 2; }
__host__ __device__ __forceinline__ int perm32(int rho) { const int n = rho >> 4, i = rho & 15; return 8 * (i >> 2) + 4 * n + (i & 3); }
struct Unit { int pm, pn; };
struct Gemm { const bf16_t* A; const bf16_t* Bt; int lda, ldb, K; };
struct StaticOrder {
    int nM, nN, nwg, G, c, wgm;
    __device__ void init(int M, int N, int G_, int c_, int wgm_ = WGM) { nM = M / BM; nN = N / BM; nwg = nM * nN; G = G_; c = c_; wgm = wgm_; }
    __device__ bool next(int i, Unit& u) const {
        const long L = (long)i * G + c; if (L >= nwg) return false;
        int wgid = (int)L; { const int q = nwg / NXCD, r = nwg % NXCD, xcd = wgid % NXCD, off = wgid / NXCD; wgid = (xcd < r ? xcd * (q + 1) : r * (q + 1) + (xcd - r) * q) + off; }
        const int nig = wgm * nN, gid = wgid / nig, fm = gid * wgm, gsz = (nM - fm) < wgm ? (nM - fm) : wgm;
        u.pm = fm + ((wgid % nig) % gsz); u.pn = (wgid % nig) / gsz; return true;
    }
};
template <class Epi, class Sched>
__device__ __forceinline__ void gemm_phase(LAS unsigned char* lds, const Gemm g, const Sched& S, const Epi& E, int wid) {
    const int lane = lane_id(), tid = wid * 64 + lane, wr = wid >> 2, wc = wid & 3, fr = lane & 15, fq = lane >> 4;
    const int K = g.K, nt = K / BK;
    unsigned voffA[2], voffB[2];
#pragma unroll
    for (int i = 0; i < 2; ++i) { int R, C; stage_rc(tid * 16 + i * 8192, R, C); const int Rb = Epi::PERM ? ((R & ~31) + perm32(R & 31)) : R;
        voffA[i] = (unsigned)(R * g.lda + C) * 2u; voffB[i] = (unsigned)(Rb * g.ldb + C) * 2u; }
    const size_t kstep = (size_t)(BK * 2);
    const size_t hstepA = (size_t)HALF * g.lda * 2, hstepB = (size_t)HALF * g.ldb * 2;
    const size_t tstepA = 2 * hstepA, tstepB = 2 * hstepB;
    const unsigned ldsw = (unsigned)wid * 1024u;
    const int aoff = lds_byte(wr * 64 + fr, fq * 8), boff = lds_byte(wc * 32 + fr, fq * 8);
#define PG8_SA(b, h) (((b) * 2 + (h)) * HTB)
#define PG8_SB(b, h) ((4 + (b) * 2 + (h)) * HTB)
#define PG8_STAGE(bufoff, gbase, voff) do { _Pragma("unroll") for (int _i = 0; _i < 2; ++_i) \
        __builtin_amdgcn_global_load_lds((const unsigned*)((const char*)(gbase) + (voff)[_i]), (LAS unsigned*)(lds + (bufoff) + ldsw + _i * 8192), 16, 0, 0); } while (0)
#define PG8_LDA(dst, b, h) do { _Pragma("unroll") for (int m = 0; m < 4; ++m) _Pragma("unroll") for (int k = 0; k < 2; ++k) dst[m][k] = *(const LAS bf16x8*)(lds + PG8_SA(b, h) + aoff + m * 2048 + k * 1024); } while (0)
#define PG8_LDB(dst, b, h) do { _Pragma("unroll") for (int n = 0; n < 2; ++n) _Pragma("unroll") for (int k = 0; k < 2; ++k) dst[n][k] = *(const LAS bf16x8*)(lds + PG8_SB(b, h) + boff + n * 2048 + k * 1024); } while (0)
#define PG8_MMA(ai, bj, At, Bt) do { __builtin_amdgcn_s_setprio(1); _Pragma("unroll") for (int m = 0; m < 4; ++m) _Pragma("unroll") for (int n = 0; n < 2; ++n) _Pragma("unroll") for (int k = 0; k < 2; ++k) \
        acc[ai][bj][m][n] = __builtin_amdgcn_mfma_f32_16x16x32_bf16(Bt[n][k], At[m][k], acc[ai][bj][m][n], 0, 0, 0); __builtin_amdgcn_s_setprio(0); } while (0)
#define PG8_WAIT_V(n) asm volatile("s_waitcnt vmcnt(" #n ")" ::: "memory")
#define PG8_WAIT_L(n) asm volatile("s_waitcnt lgkmcnt(" #n ")" ::: "memory")
#define PG8_BAR __builtin_amdgcn_s_barrier()
#define PG8_SCHED __builtin_amdgcn_sched_barrier(0)
    Unit cur, nxt; int ui = 0;
    if (!S.next(0, cur)) return;
    f32x4 acc[2][2][4][2];
#pragma unroll
    for (int a = 0; a < 2; ++a)
#pragma unroll
        for (int b = 0; b < 2; ++b)
#pragma unroll
            for (int m = 0; m < 4; ++m)
#pragma unroll
                for (int n = 0; n < 2; ++n) acc[a][b][m][n] = (f32x4){0.f, 0.f, 0.f, 0.f};
    bf16x8 At[4][2], B0[2][2], B1[2][2];
    const char* cA = (const char*)g.A + (size_t)cur.pm * tstepA; const char* cB = (const char*)g.Bt + (size_t)cur.pn * tstepB;
    PG8_STAGE(PG8_SB(0, 0), cB, voffB); PG8_STAGE(PG8_SB(0, 1), cB + hstepB, voffB); PG8_STAGE(PG8_SA(0, 0), cA, voffA); PG8_STAGE(PG8_SA(0, 1), cA + hstepA, voffA);
    if (wr == 1) PG8_BAR;
    PG8_WAIT_V(2); PG8_BAR;
    PG8_STAGE(PG8_SB(1, 0), cB + kstep, voffB); PG8_STAGE(PG8_SA(1, 0), cA + kstep, voffA); PG8_STAGE(PG8_SB(1, 1), cB + hstepB + kstep, voffB);
    PG8_WAIT_V(6); PG8_BAR;
    for (;;) {
        const bool has_next = S.next(ui + 1, nxt);
        const char* nA = has_next ? (const char*)g.A + (size_t)nxt.pm * tstepA : cA; const char* nB = has_next ? (const char*)g.Bt + (size_t)nxt.pn * tstepB : cB;
        for (int t = 0; t < nt; t += 2) {
            const bool last = (t == nt - 2);
            const char* a1 = cA + (size_t)(t + 1) * kstep;
            const char* a2 = last ? nA : cA + (size_t)(t + 2) * kstep; const char* b2 = last ? nB : cB + (size_t)(t + 2) * kstep;
            const char* a3 = a2 + kstep; const char* b3 = b2 + kstep;
            PG8_LDB(B0, 0, 0); PG8_LDB(B1, 0, 1); PG8_SCHED; PG8_LDA(At, 0, 0); PG8_STAGE(PG8_SA(1, 1), a1 + hstepA, voffA);
            PG8_WAIT_V(8); PG8_WAIT_L(0); PG8_BAR; PG8_MMA(0, 0, At, B0); PG8_MMA(0, 1, At, B1); PG8_BAR; PG8_SCHED;
            PG8_LDA(At, 0, 1); PG8_STAGE(PG8_SB(0, 0), b2, voffB); PG8_STAGE(PG8_SB(0, 1), b2 + hstepB, voffB); PG8_STAGE(PG8_SA(0, 0), a2, voffA);
            PG8_WAIT_V(8); PG8_WAIT_L(0); PG8_BAR; PG8_MMA(1, 0, At, B0); PG8_MMA(1, 1, At, B1); PG8_BAR; PG8_SCHED;
            PG8_LDB(B0, 1, 0); PG8_LDB(B1, 1, 1); PG8_SCHED; PG8_LDA(At, 1, 0); PG8_STAGE(PG8_SA(0, 1), a2 + hstepA, voffA);
            PG8_WAIT_V(8); PG8_WAIT_L(0); PG8_BAR; PG8_MMA(0, 0, At, B0); PG8_MMA(0, 1, At, B1); PG8_BAR; PG8_SCHED;
            PG8_LDA(At, 1, 1); PG8_STAGE(PG8_SB(1, 0), b3, voffB); PG8_STAGE(PG8_SB(1, 1), b3 + hstepB, voffB); PG8_STAGE(PG8_SA(1, 0), a3, voffA);
            PG8_WAIT_V(8); PG8_WAIT_L(0); PG8_BAR; PG8_MMA(1, 0, At, B0); PG8_MMA(1, 1, At, B1); PG8_BAR; PG8_SCHED;
        }
        if (wr == 0) PG8_BAR;
        if constexpr (Epi::XCHG) E.fused(acc, cur, wid, wr, wc, fr, fq, lds + STAGE_BYTES); else E(acc, cur, wr, wc, fr, fq);
        if (!has_next) break;
#pragma unroll
        for (int a = 0; a < 2; ++a)
#pragma unroll
            for (int b = 0; b < 2; ++b)
#pragma unroll
                for (int m = 0; m < 4; ++m)
#pragma unroll
                    for (int n = 0; n < 2; ++n) acc[a][b][m][n] = (f32x4){0.f, 0.f, 0.f, 0.f};
        cur = nxt; cA = nA; cB = nB; ++ui;
        if (wr == 1) PG8_BAR;
    }
    PG8_WAIT_V(0);
    PG8_BAR;
#undef PG8_SA
#undef PG8_SB
#undef PG8_STAGE
#undef PG8_LDA
#undef PG8_LDB
#undef PG8_MMA
#undef PG8_WAIT_V
#undef PG8_WAIT_L
#undef PG8_BAR
#undef PG8_SCHED
}

#define EPI_ROWS_BEGIN  _Pragma("unroll") for (int ai = 0; ai < 2; ++ai) _Pragma("unroll") for (int m = 0; m < 4; ++m) { const int row = u.pm * BM + wr * 64 + fr + ai * HALF + m * 16;
#define EPI_ROWS_END }
__device__ __forceinline__ u32x4 pack8(const f32x4 v0, const f32x4 v1) { u32x4 w; w.x = cvt_pk_bf16(v0[0], v0[1]); w.y = cvt_pk_bf16(v0[2], v0[3]); w.z = cvt_pk_bf16(v1[0], v1[1]); w.w = cvt_pk_bf16(v1[2], v1[3]); return w; }

struct EpiInProj { static constexpr bool PERM = true, XCHG = false; bf16_t* proj; float* small;
    __device__ __forceinline__ void operator()(const f32x4 (&acc)[2][2][4][2], const Unit& u, int wr, int wc, int fr, int fq) const {
        if (u.pn < 38) { const int col0 = u.pn * BM + wc * 32 + 8 * fq;
            EPI_ROWS_BEGIN bf16_t* rowp = proj + (size_t)row * NP + col0;
#pragma unroll
                for (int bj = 0; bj < 2; ++bj) *(u32x4*)(rowp + bj * HALF) = pack8(acc[ai][bj][m][0], acc[ai][bj][m][1]);
            EPI_ROWS_END
        } else if (wc == 0) {
            EPI_ROWS_BEGIN float* rp = small + (size_t)row * 32 + 8 * fq; *(f32x4*)rp = acc[ai][0][m][0]; *(f32x4*)(rp + 4) = acc[ai][0][m][1];
            EPI_ROWS_END
        }
    }
};
template <int ACT> struct EpiBf16 { static constexpr bool PERM = true, XCHG = false; bf16_t* O; int ldc; const float* bias;
    __device__ __forceinline__ void operator()(const f32x4 (&acc)[2][2][4][2], const Unit& u, int wr, int wc, int fr, int fq) const {
        const int col0 = u.pn * BM + wc * 32 + 8 * fq;
        f32x4 bv[2][2];
#pragma unroll
        for (int bj = 0; bj < 2; ++bj)
#pragma unroll
            for (int n = 0; n < 2; ++n) bv[bj][n] = ACT ? *(const f32x4*)(bias + col0 + bj * HALF + 4 * n) : (f32x4){0.f, 0.f, 0.f, 0.f};
        EPI_ROWS_BEGIN bf16_t* rowp = O + (size_t)row * ldc + col0;
#pragma unroll
            for (int bj = 0; bj < 2; ++bj) { f32x4 v0 = acc[ai][bj][m][0], v1 = acc[ai][bj][m][1];
                if (ACT) { v0 = v0 + bv[bj][0]; v1 = v1 + bv[bj][1];
#pragma unroll
                    for (int i = 0; i < 4; ++i) { v0[i] = gelu_tanh(v0[i]); v1[i] = gelu_tanh(v1[i]); } }
                *(u32x4*)(rowp + bj * HALF) = pack8(v0, v1); }
        EPI_ROWS_END
    }
};
template <bool TR> struct EpiCmp2 { static constexpr bool PERM = true, XCHG = false; bf16_t* O;
    __device__ __forceinline__ void operator()(const f32x4 (&acc)[2][2][4][2], const Unit& u, int wr, int wc, int fr, int fq) const {
        const int col0 = wc * 32 + 8 * fq;
        EPI_ROWS_BEGIN
            if (!TR) { *(u32x4*)(O + (size_t)row * 128 + col0) = pack8(acc[ai][0][m][0], acc[ai][0][m][1]); }
            else {
#pragma unroll
                for (int n = 0; n < 2; ++n)
#pragma unroll
                    for (int i = 0; i < 4; ++i) { const int d = col0 + 4 * n + i; O[((size_t)(row >> 6) * 128 + d) * 64 + (row & 63)] = (bf16_t)(cvt_pk_bf16(acc[ai][0][m][n][i], 0.f) & 0xffffu); }
            }
        EPI_ROWS_END
    }
};
template <bool SECOND> struct EpiMerge { static constexpr bool PERM = true, XCHG = false; const bf16_t* gate; bf16_t* O;
    __device__ __forceinline__ void operator()(const f32x4 (&acc)[2][2][4][2], const Unit& u, int wr, int wc, int fr, int fq) const {
        const int col0 = u.pn * BM + wc * 32 + 8 * fq;
        EPI_ROWS_BEGIN
#pragma unroll
            for (int bj = 0; bj < 2; ++bj) { const u32x4 gv = *(const u32x4*)(gate + (size_t)row * NP + col0 + bj * HALF);
                f32x4 v0 = acc[ai][bj][m][0], v1 = acc[ai][bj][m][1];
                v0[0] *= sigmoidf_(bflo(gv.x)); v0[1] *= sigmoidf_(bfhi(gv.x)); v0[2] *= sigmoidf_(bflo(gv.y)); v0[3] *= sigmoidf_(bfhi(gv.y));
                v1[0] *= sigmoidf_(bflo(gv.z)); v1[1] *= sigmoidf_(bfhi(gv.z)); v1[2] *= sigmoidf_(bflo(gv.w)); v1[3] *= sigmoidf_(bfhi(gv.w));
                bf16_t* op = O + (size_t)row * DM + col0 + bj * HALF;
                if (SECOND) { const u32x4 ov = *(const u32x4*)op;
                    v0[0] += bflo(ov.x); v0[1] += bfhi(ov.x); v0[2] += bflo(ov.y); v0[3] += bfhi(ov.y); v1[0] += bflo(ov.z); v1[1] += bfhi(ov.z); v1[2] += bflo(ov.w); v1[3] += bfhi(ov.w); }
                *(u32x4*)op = pack8(v0, v1); }
        EPI_ROWS_END
    }
};
struct EpiUpAct { static constexpr bool PERM = true, XCHG = false; bf16_t* act; float* SU; float* SV; const float* conv_w; const float* conv_b;
    __device__ __forceinline__ void operator()(const f32x4 (&acc)[2][2][4][2], const Unit& u, int wr, int wc, int fr, int fq) const {
        const int lane = fq * 16 + fr;
        const int s1a = lane - 1, s1b = lane + 15, s2a = lane - 2, s2b = lane + 14;
#pragma unroll
        for (int n = 0; n < 2; ++n) {
            const int j0 = u.pn * 128 + wc * 32 + 8 * fq + 4 * n;
            const f32x4 w0 = *(const f32x4*)(conv_w + j0), w1 = *(const f32x4*)(conv_w + DFF + j0), w2 = *(const f32x4*)(conv_w + 2 * DFF + j0), cb = *(const f32x4*)(conv_b + j0);
#pragma unroll
            for (int ai = 0; ai < 2; ++ai)
#pragma unroll
                for (int m = 0; m < 4; ++m) {
                    const int row = u.pm * BM + wr * 64 + fr + ai * HALF + m * 16;
                    const int grp = row >> 6;
                    f32x4 o;
#pragma unroll
                    for (int i = 0; i < 4; ++i) {
                        const float uc = acc[ai][0][m][n][i];
                        const float up = (m > 0) ? acc[ai][0][m > 0 ? m - 1 : 0][n][i] : 0.f;
                        const float a1 = __shfl(uc, s1a), b1 = __shfl(up, s1b), a2 = __shfl(uc, s2a), b2 = __shfl(up, s2b);
                        const float p1 = (fr >= 1) ? a1 : b1, p2 = (fr >= 2) ? a2 : b2;
                        const float c = cb[i] + w0[i] * p2 + w1[i] * p1 + w2[i] * uc;
                        o[i] = gelu_tanh(c) * acc[ai][1][m][n][i];
                    }
                    if (m == 0 && fr < 2) {
                        *(f32x4*)(SU + ((size_t)grp * 4 + 2 + fr) * DFF + j0) = acc[ai][0][m][n]; *(f32x4*)(SV + ((size_t)grp * 2 + fr) * DFF + j0) = acc[ai][1][m][n];
                    } else {
                        u32x2 w; w.x = cvt_pk_bf16(o[0], o[1]); w.y = cvt_pk_bf16(o[2], o[3]); *(u32x2*)(act + (size_t)row * DFF + j0) = w;
                    }
                    if (m == 3 && fr >= 14) *(f32x4*)(SU + ((size_t)(grp + 1) * 4 + (fr - 14)) * DFF + j0) = acc[ai][0][m][n];
                }
        }
    }
};
struct EpiResid { static constexpr bool PERM = false, XCHG = false; const float* base; float* out; bool dry;
    __device__ __forceinline__ void operator()(const f32x4 (&acc)[2][2][4][2], const Unit& u, int wr, int wc, int fr, int fq) const {
        const int col0 = u.pn * BM + wc * 32 + 4 * fq;
        EPI_ROWS_BEGIN const size_t off = (size_t)row * DM + col0;
#pragma unroll
            for (int bj = 0; bj < 2; ++bj)
#pragma unroll
                for (int n = 0; n < 2; ++n) { const f32x4 bs = *(const f32x4*)(base + off + bj * HALF + n * 16); if (!dry) *(f32x4*)(out + off + bj * HALF + n * 16) = bs + acc[ai][bj][m][n]; }
        EPI_ROWS_END
    }
};
struct RowStats { unsigned* xbuf; unsigned* cnt; };
__device__ __forceinline__ bool row_rstd_exchange(const f32x4 (&v)[2][2][4][2], const Unit& u, int wid, int wr, int wc, int fr, int fq, LAS unsigned char* lx, const RowStats& st) {
    LAS float* Pp = (LAS float*)lx;
    LAS float* Sp = (LAS float*)(lx + 4096);
    LAS unsigned* flag = (LAS unsigned*)(lx + 4096 + 1024);
#pragma unroll
    for (int ai = 0; ai < 2; ++ai)
#pragma unroll
        for (int m = 0; m < 4; ++m) { float s = 0.f;
#pragma unroll
            for (int bj = 0; bj < 2; ++bj)
#pragma unroll
                for (int n = 0; n < 2; ++n) { const f32x4 x = v[ai][bj][m][n]; s += (x[0] * x[0] + x[1] * x[1]) + (x[2] * x[2] + x[3] * x[3]); }
            s += __shfl_xor(s, 16); s += __shfl_xor(s, 32);
            if (fq == 0) Pp[(ai * HALF + wr * 64 + m * 16 + fr) * 4 + wc] = s; }
    asm volatile("s_waitcnt lgkmcnt(0)" ::: "memory"); __builtin_amdgcn_s_barrier(); asm volatile("" ::: "memory");
    const int lane = fq * 16 + fr; const int row = wid * 32 + (lane & 31);
    if (lane < 32) { const f32x4 p = *(const LAS f32x4*)(Pp + row * 4); const float tot = (p[0] + p[1]) + (p[2] + p[3]);
        __hip_atomic_store(st.xbuf + ((size_t)(u.pm * BM + row)) * 8 + u.pn, __float_as_uint(tot), __ATOMIC_RELAXED, __HIP_MEMORY_SCOPE_AGENT); }
    asm volatile("s_waitcnt vmcnt(0)" ::: "memory");
    if (lane == 0) __hip_atomic_fetch_add(st.cnt + 64 * u.pm, 1u, __ATOMIC_RELAXED, __HIP_MEMORY_SCOPE_AGENT);
    if (wid == 0) {
        bool dead = false; unsigned spins = 0;
        while ((unsigned)__builtin_amdgcn_readfirstlane(__hip_atomic_load(st.cnt + 64 * u.pm, __ATOMIC_RELAXED, __HIP_MEMORY_SCOPE_AGENT)) < 64u) {
            __builtin_amdgcn_s_sleep(2); if (++spins > (1u << 20)) { dead = true; break; } }
        __builtin_amdgcn_fence(__ATOMIC_ACQUIRE, "agent");
        if (lane == 0) flag[0] = dead ? 1u : 0u;
    }
    asm volatile("s_waitcnt vmcnt(0) lgkmcnt(0)" ::: "memory"); __builtin_amdgcn_s_barrier(); asm volatile("" ::: "memory");
    if (lane < 32) { const unsigned* slot = st.xbuf + (size_t)(u.pm * BM + row) * 8; float t = 0.f;
#pragma unroll
        for (int k = 0; k < 8; ++k) t += __uint_as_float(__hip_atomic_load(slot + k, __ATOMIC_RELAXED, __HIP_MEMORY_SCOPE_AGENT));
        Sp[row] = rsqrtf(t * (1.0f / DM) + EPS); }
    asm volatile("s_waitcnt vmcnt(0) lgkmcnt(0)" ::: "memory"); __builtin_amdgcn_s_barrier(); asm volatile("" ::: "memory");
    return flag[0] != 0u;
}
struct EpiOutNorm { static constexpr bool PERM = false, XCHG = true; const float* base; float* out; bf16_t* hn; const float* g; RowStats st;
    __device__ __forceinline__ void fused(f32x4 (&acc)[2][2][4][2], const Unit& u, int wid, int wr, int wc, int fr, int fq, LAS unsigned char* lx) const {
        const int col0 = u.pn * BM + wc * 32 + 4 * fq;
        EPI_ROWS_BEGIN const size_t off = (size_t)row * DM + col0;
#pragma unroll
            for (int bj = 0; bj < 2; ++bj)
#pragma unroll
                for (int n = 0; n < 2; ++n) { acc[ai][bj][m][n] += *(const f32x4*)(base + off + bj * HALF + n * 16); *(f32x4*)(out + off + bj * HALF + n * 16) = acc[ai][bj][m][n]; }
            asm volatile("" ::: "memory");
        EPI_ROWS_END
        const bool bad = row_rstd_exchange(acc, u, wid, wr, wc, fr, fq, lx, st);
        const float qn = __builtin_nanf(""); const LAS float* Sp = (const LAS float*)(lx + 4096);
        EPI_ROWS_BEGIN const size_t off = (size_t)row * DM + col0; const float r = bad ? qn : Sp[ai * HALF + wr * 64 + m * 16 + fr];
#pragma unroll
            for (int bj = 0; bj < 2; ++bj)
#pragma unroll
                for (int n = 0; n < 2; ++n) { const f32x4 x = acc[ai][bj][m][n], gg = *(const f32x4*)(g + col0 + bj * HALF + n * 16); u32x2 w; w.x = cvt_pk_bf16(x[0] * r * gg[0], x[1] * r * gg[1]); w.y = cvt_pk_bf16(x[2] * r * gg[2], x[3] * r * gg[3]);
                    *(u32x2*)(hn + off + bj * HALF + n * 16) = w; }
            asm volatile("" ::: "memory");
        EPI_ROWS_END
    }
};
struct EpiFinalNorm { static constexpr bool PERM = false, XCHG = true; float* out; const float* g; RowStats st;
    __device__ __forceinline__ void fused(f32x4 (&acc)[2][2][4][2], const Unit& u, int wid, int wr, int wc, int fr, int fq, LAS unsigned char* lx) const {
        const int col0 = u.pn * BM + wc * 32 + 4 * fq;
        EPI_ROWS_BEGIN const size_t off = (size_t)row * DM + col0;
#pragma unroll
            for (int bj = 0; bj < 2; ++bj)
#pragma unroll
                for (int n = 0; n < 2; ++n) acc[ai][bj][m][n] += *(const f32x4*)(out + off + bj * HALF + n * 16);
            asm volatile("" : "+v"(acc[ai][0][m][0]), "+v"(acc[ai][0][m][1]), "+v"(acc[ai][1][m][0]), "+v"(acc[ai][1][m][1]) :: "memory");
        EPI_ROWS_END
        const bool bad = row_rstd_exchange(acc, u, wid, wr, wc, fr, fq, lx, st);
        const float qn = __builtin_nanf(""); const LAS float* Sp = (const LAS float*)(lx + 4096);
        EPI_ROWS_BEGIN const size_t off = (size_t)row * DM + col0; const float r = bad ? qn : Sp[ai * HALF + wr * 64 + m * 16 + fr];
#pragma unroll
            for (int bj = 0; bj < 2; ++bj)
#pragma unroll
                for (int n = 0; n < 2; ++n) *(f32x4*)(out + off + bj * HALF + n * 16) = acc[ai][bj][m][n] * r * *(const f32x4*)(g + col0 + bj * HALF + n * 16);
            asm volatile("" ::: "memory");
        EPI_ROWS_END
    }
};
}

struct Args {
    const float* x; const float* attn_g; const float* w_in; const float* pos_k; const float* w1_k; const float* w2_k; const float* pos_v; const float* w1_v; const float* w2_v;
    const float* rel; const float* fbias; const float* w_bn; const float* w_bf; const float* w_out; const float* ffn_g; const float* w_up; const float* conv_w; const float* conv_b;
    const float* w_down; const float* final_g;
    float* out; unsigned char* ws; int probe; int pad;
};

template <class F>
__device__ __forceinline__ void transpose_item(const float* W, int ldw, int Ksrc, bf16_t* WT, int ldt, int k0, int n0, F colmap, LAS float* scr, int lane) {
    const int n4 = (lane & 7) * 4; float sc; const int col = colmap(n0 + n4, sc);
    f32x4 v[8];
#pragma unroll
    for (int i = 0; i < 8; ++i) { const int kk = (lane >> 3) + 8 * i; v[i] = (f32x4){0.f, 0.f, 0.f, 0.f}; if (col >= 0 && (k0 + kk) < Ksrc) v[i] = *(const f32x4*)(W + (size_t)(k0 + kk) * ldw + col); }
#pragma unroll
    for (int i = 0; i < 8; ++i) { const int kk = (lane >> 3) + 8 * i; LAS float* d = scr + kk * 33 + n4; d[0] = v[i].x * sc; d[1] = v[i].y * sc; d[2] = v[i].z * sc; d[3] = v[i].w * sc; }
    asm volatile("s_waitcnt lgkmcnt(0)" ::: "memory");
    const int c = lane & 7;
#pragma unroll
    for (int j = 0; j < 4; ++j) { const int nn = (lane >> 3) + 8 * j; const LAS float* s = scr + (8 * c) * 33 + nn;
        u32x4 o; o.x = cvt_pk_bf16(s[0 * 33], s[1 * 33]); o.y = cvt_pk_bf16(s[2 * 33], s[3 * 33]); o.z = cvt_pk_bf16(s[4 * 33], s[5 * 33]); o.w = cvt_pk_bf16(s[6 * 33], s[7 * 33]);
        *(u32x4*)(WT + (size_t)(n0 + nn) * ldt + k0 + 8 * c) = o; }
    asm volatile("s_waitcnt lgkmcnt(0)" ::: "memory");
}
struct MapIn { __device__ __forceinline__ int operator()(int n, float& sc) const {
    sc = (n < 1024 || (n >= C_QF && n < C_KF)) ? QSCALE : 1.0f;
    if (n < 2560) return n; if (n < 5632) return n + 24; if (n < 9728) return n + 32; if (n < 9752) return 2560 + (n - 9728); if (n < 9760) return 5656 + (n - 9752); return -1; } };
struct MapUp { __device__ __forceinline__ int operator()(int n, float& sc) const { sc = 1.0f; const int pn = n >> 8, c = n & 255; return ((c >> 7) ? DFF : 0) + pn * 128 + (c & 127); } };
struct MapId { int N; __device__ __forceinline__ int operator()(int n, float& sc) const { sc = 1.0f; return n < N ? n : -1; } };

__device__ __forceinline__ void rms_row_bf16(const float* xrow, const float* g, bf16_t* orow, int lane) {
    f32x4 v[8]; float s = 0.f;
#pragma unroll
    for (int j = 0; j < 8; ++j) { v[j] = *((const f32x4*)xrow + lane + 64 * j); s += (v[j].x * v[j].x + v[j].y * v[j].y) + (v[j].z * v[j].z + v[j].w * v[j].w); }
    const float rstd = rsqrtf(wave_sum(s) * (1.f / DM) + EPS);
#pragma unroll
    for (int j = 0; j < 8; ++j) { const f32x4 gg = *((const f32x4*)g + lane + 64 * j); u32x2 o; o.x = cvt_pk_bf16(v[j].x * rstd * gg.x, v[j].y * rstd * gg.y); o.y = cvt_pk_bf16(v[j].z * rstd * gg.z, v[j].w * rstd * gg.w);
        *((u32x2*)orow + lane + 64 * j) = o; }
}
__device__ __forceinline__ void rms_row_f32_inplace(float* xrow, const float* g, int lane) {
    f32x4 v[8]; float s = 0.f;
#pragma unroll
    for (int j = 0; j < 8; ++j) { v[j] = *((const f32x4*)xrow + lane + 64 * j); s += (v[j].x * v[j].x + v[j].y * v[j].y) + (v[j].z * v[j].z + v[j].w * v[j].w); }
    const float rstd = rsqrtf(wave_sum(s) * (1.f / DM) + EPS);
#pragma unroll
    for (int j = 0; j < 8; ++j) { const f32x4 gg = *((const f32x4*)g + lane + 64 * j); f32x4 o; o.x = v[j].x * rstd * gg.x; o.y = v[j].y * rstd * gg.y; o.z = v[j].z * rstd * gg.z; o.w = v[j].w * rstd * gg.w;
        *((f32x4*)xrow + lane + 64 * j) = o; }
}

__device__ __forceinline__ int kappa32(int r) { return (r & 0x13) | ((r & 4) << 1) | ((r & 8) >> 1); }
#define MFMA32(a, b, c) __builtin_amdgcn_mfma_f32_32x32x16_bf16((a), (b), (c), 0, 0, 0)
#define MFMA16(a, b, c) __builtin_amdgcn_mfma_f32_16x16x32_bf16((a), (b), (c), 0, 0, 0)

struct AttnP { bf16_t* proj; const bf16_t* kc; const bf16_t* vtf; const bf16_t* vtw; const bf16_t* vct; const float* cum2; const float* lut2; const float* small; bf16_t* ow; float* lse; const float* kmax2; };

template <int MODE>
__device__ __forceinline__ void attn_unit(LAS unsigned char* lds, const AttnP& P, int b, int head_, int qb, int wid, bool dry = false) {
    const int lane = lane_id(), tid = wid * 64 + lane, r32 = lane & 31, hi = lane >> 5;
    const int head = (MODE == 1) ? head_ * 4 + (wid >> 1) : head_;
    const int hl = (MODE == 1) ? (wid >> 1) : 0;
    const int g = head >> 2;
    const int t0 = (MODE == 1) ? qb * 64 : qb * 256, qw0 = (MODE == 1) ? t0 + (wid & 1) * 32 : t0 + wid * 32, t = qw0 + r32;
    const size_t gt = (size_t)b * S + t;
    bf16x8 qf[8];
    { const bf16_t* qp = P.proj + gt * NP + (MODE == 0 ? C_QF : C_QN) + head * 128 + hi * 8;
#pragma unroll
      for (int ks = 0; ks < 8; ++ks) qf[ks] = *(const bf16x8*)(qp + ks * 16); }
    const bf16_t* kbase; size_t kstride; const bf16_t* vbase; int kt0, kt1;
    if (MODE == 0) { kbase = P.proj + (size_t)b * S * NP + C_KF + head * 128; kstride = NP; vbase = P.vtf + (size_t)(b * 8 + head) * 256 * 8192; kt0 = 0; kt1 = (t0 + 256) / 64; }
    else if (MODE == 1) { kbase = P.proj + (size_t)b * S * NP + C_KW + g * 128; kstride = NP; vbase = P.vtw + (size_t)(b * 2 + g) * 256 * 8192; kt0 = (t0 >= 512) ? (t0 - 512) / 64 : 0; kt1 = t0 / 64 + 1; }
    else { kbase = P.kc + (size_t)(b * 2 + g) * 1024 * 128; kstride = 128; vbase = P.vct + (size_t)(b * 2 + g) * 16 * 8192; kt0 = 0; kt1 = (t0 / 16 + 14) / 64 + 1; }
    LAS float* lutl = (LAS float*)(lds + ABIAS) + hl * 512;
    if (MODE == 2) lutl[tid] = P.lut2[head * 512 + tid];
    if (MODE == 1) {
#pragma unroll
        for (int i = 0; i < 4; ++i) ((LAS float*)(lds + ABIAS))[tid + 512 * i] = P.lut2[(g * 4) * 512 + tid + 512 * i]; }
    const float* cump = P.cum2 + (size_t)(b * 8 + head) * S;

    u32x4 kreg[2], vreg[2]; float ckreg = 0.f;
#define AT_LOAD(kt) do { _Pragma("unroll") for (int p = 0; p < 2; ++p) { const int ci = tid + 512 * p; \
        kreg[p] = *(const u32x4*)(kbase + (size_t)((kt) * 64 + (ci >> 4)) * kstride + (ci & 15) * 8); \
        vreg[p] = *(const u32x4*)(vbase + (size_t)(kt) * 8192 + (ci >> 3) * 64 + (ci & 7) * 8); } \
        if (MODE == 0 && tid < 64) ckreg = cump[(kt) * 64 + tid]; } while (0)
#define AT_STORE(buf) do { _Pragma("unroll") for (int p = 0; p < 2; ++p) { const int ci = tid + 512 * p; const int key = ci >> 4, c = ci & 15, d = ci >> 3, c2 = ci & 7; \
        *(LAS u32x4*)(lds + (buf) * AKT + key * 272 + c * 16) = kreg[p]; \
        *(LAS u32x4*)(lds + AV0 + (buf) * AVT + d * 144 + c2 * 16) = vreg[p]; } \
        if (MODE == 0 && tid < 64) lutl[(buf) * 64 + tid] = -ckreg; } while (0)

    float m_run = -1e30f, l_run = 0.f;
    f32x16 O[4];
#pragma unroll
    for (int dt = 0; dt < 4; ++dt)
#pragma unroll
        for (int i = 0; i < 16; ++i) O[dt][i] = 0.f;
    float qkb = 0.f;
    if (MODE == 0) { float ss = 0.f;
#pragma unroll
        for (int ks = 0; ks < 8; ++ks) { const u32x4 w = __builtin_bit_cast(u32x4, qf[ks]);
            ss += bflo(w.x) * bflo(w.x) + bfhi(w.x) * bfhi(w.x) + bflo(w.y) * bflo(w.y) + bfhi(w.y) * bfhi(w.y) + bflo(w.z) * bflo(w.z) + bfhi(w.z) * bfhi(w.z) + bflo(w.w) * bflo(w.w) + bfhi(w.w) * bfhi(w.w); }
        ss += __shfl_xor(ss, 32);
        qkb = sqrtf(ss) * sqrtf(P.kmax2[b * 8 + head]) * 1.001f; }
    LAS unsigned* xflag = (LAS unsigned*)(lds + ABIAS + 1024);
    AT_LOAD(kt1 - 1); AT_STORE(0); __syncthreads();
    const int kr0 = kappa32(r32);
    for (int kt = kt1 - 1; kt >= kt0; --kt) {
        const int buf = (kt1 - 1 - kt) & 1;
        if (kt > kt0) AT_LOAD(kt - 1);
        const int k0 = kt * 64;
        bool inval, needmask;
        if (MODE == 0) { inval = k0 > qw0 + 31; needmask = k0 + 63 > qw0; }
        else if (MODE == 1) { inval = (k0 > qw0 + 31) || (k0 + 63 < qw0 - 511); needmask = (k0 + 63 > qw0) || (k0 < qw0 + 31 - 511); }
        else { inval = 16 * k0 + 31 > qw0 + 31; needmask = 16 * (k0 + 63) + 31 > qw0; }
        bool farc = false;
        if (MODE == 1) farc = !needmask && (qw0 - (k0 + 63) >= 127);
        if (MODE == 2) farc = !needmask && (qw0 - 16 * (k0 + 63) - 31 >= 127);
        if (!inval) {
#pragma unroll
          for (int sub = 0; sub < 2; ++sub) {
            const LAS unsigned char* kb = lds + buf * AKT + (kr0 + 32 * sub) * 272 + hi * 16;
            f32x16 s0;
#pragma unroll
            for (int i = 0; i < 16; ++i) { if (MODE == 0) { const int kl = 32 * sub + 16 * (i >> 3) + 8 * hi + (i & 7); s0[i] = lutl[buf * 64 + kl]; } else s0[i] = 0.f; }
#pragma unroll
            for (int ks = 0; ks < 8; ++ks) { const bf16x8 ka = *(const LAS bf16x8*)(kb + ks * 32); s0 = MFMA32(ka, qf[ks], s0); }
            __builtin_amdgcn_sched_barrier(0);
            float mx = -1e30f;
            if (MODE != 0 && farc) {
                const float c31 = lutl[511];
#pragma unroll
                for (int i = 0; i < 16; ++i) { s0[i] += c31; mx = fmaxf(mx, s0[i]); }
            } else
#pragma unroll
            for (int i = 0; i < 16; ++i) {
                const int kl = 32 * sub + 16 * (i >> 3) + 8 * hi + (i & 7);
                float b0 = 0.f; bool v0 = true;
                if (MODE == 0) { if (needmask) v0 = (k0 + kl) <= t; }
                else { int d0;
                    if (MODE == 1) { d0 = t - (k0 + kl); v0 = (d0 >= 0) && (d0 < 512); }
                    else { d0 = t - 16 * (k0 + kl) - 31; v0 = d0 >= 0; }
                    b0 = lutl[min(max(d0, 0), 511)]; }
                float a0 = s0[i] + b0;
                if (needmask) a0 = v0 ? a0 : -1e30f;
                s0[i] = a0; mx = fmaxf(mx, a0);
            }
            mx = xh_max(mx);
            if (__any(mx > m_run)) {
                const float m_new = fmaxf(m_run, mx); const float alpha = fexp2(m_run - m_new); m_run = m_new; l_run *= alpha;
#pragma unroll
                for (int dt = 0; dt < 4; ++dt)
#pragma unroll
                    for (int i = 0; i < 16; ++i) O[dt][i] *= alpha;
            }
            float ls = 0.f;
#pragma unroll
            for (int i = 0; i < 16; ++i) { float p0 = fexp2(s0[i] - m_run);
                if (needmask) p0 = s0[i] > -1e29f ? p0 : 0.f;
                s0[i] = p0; ls += p0; }
            l_run += ls;
            bf16x8 pb[2];
            { u32x4 w;
              w.x = cvt_pk_bf16(s0[0], s0[1]); w.y = cvt_pk_bf16(s0[2], s0[3]); w.z = cvt_pk_bf16(s0[4], s0[5]); w.w = cvt_pk_bf16(s0[6], s0[7]); pb[0] = __builtin_bit_cast(bf16x8, w);
              w.x = cvt_pk_bf16(s0[8], s0[9]); w.y = cvt_pk_bf16(s0[10], s0[11]); w.z = cvt_pk_bf16(s0[12], s0[13]); w.w = cvt_pk_bf16(s0[14], s0[15]); pb[1] = __builtin_bit_cast(bf16x8, w); }
            const LAS unsigned char* vb = lds + AV0 + buf * AVT + r32 * 144 + hi * 16 + sub * 64;
            __builtin_amdgcn_sched_barrier(0);
#pragma unroll
            for (int dt = 0; dt < 4; ++dt) {
#pragma unroll
                for (int jj = 0; jj < 2; ++jj) { const bf16x8 vf = *(const LAS bf16x8*)(vb + dt * 32 * 144 + jj * 32);
                    O[dt] = MFMA32(vf, pb[jj], O[dt]); } }
            __builtin_amdgcn_sched_barrier(0);
          }
        }
        if (kt > kt0) AT_STORE(buf ^ 1);
        if (MODE == 0 && kt > kt0) {
            const float ub = qkb - cump[k0 - 1];
            const bool done = __all((ub - m_run) < -40.0f);
            if (lane == 0) xflag[(buf << 3) + wid] = done ? 1u : 0u;
        }
        __syncthreads();
        if (MODE == 0 && kt > kt0) {
            const u32x4 f0 = *(const LAS u32x4*)(xflag + (buf << 3)), f1 = *(const LAS u32x4*)(xflag + (buf << 3) + 4);
            if ((f0.x & f0.y & f0.z & f0.w & f1.x & f1.y & f1.z & f1.w) != 0u) { __syncthreads(); break; }
        }
    }
#undef AT_LOAD
#undef AT_STORE
    const float l_tot = xh_sum(l_run);
    float inv = l_tot > 0.f ? 1.0f / l_tot : 0.f;
    if (MODE == 1) inv *= sigmoidf_(P.small[gt * 32 + head * 3 + 2]);
    if (MODE == 2) inv *= sigmoidf_(P.small[gt * 32 + head * 3 + 0]);
    bf16_t* op = (MODE == 0) ? P.proj + gt * NP + C_QF + head * 128 : (MODE == 1) ? P.ow + gt * 1024 + head * 128 : P.proj + gt * NP + C_VF + head * 128;
    if (dry) return;
#pragma unroll
    for (int dt = 0; dt < 4; ++dt)
#pragma unroll
        for (int ig = 0; ig < 4; ++ig) { u32x2 w; w.x = cvt_pk_bf16(O[dt][4 * ig] * inv, O[dt][4 * ig + 1] * inv); w.y = cvt_pk_bf16(O[dt][4 * ig + 2] * inv, O[dt][4 * ig + 3] * inv);
            *(u32x2*)(op + dt * 32 + 8 * ig + 4 * hi) = w; }
    if (MODE == 2 && hi == 0) P.lse[gt * 8 + head] = l_tot > 0.f ? m_run + log2f(l_tot) : 0.f;
}

__device__ __forceinline__ void imp_unit(LAS unsigned char* lds, const AttnP& P, float* imp, int b, int g, int qb, int half, int wid) {
    const int lane = lane_id(), tid = wid * 64 + lane, r32 = lane & 31, hi = lane >> 5;
    const int t0 = qb * 256, qw0 = t0 + wid * 32, t = qw0 + r32;
    const size_t gt = (size_t)b * S + t;
    const bf16_t* qbase = P.proj + gt * NP + C_QN + (g * 4) * 128 + hi * 8;
    bf16x8 qc[8]; float lsec = P.lse[gt * 8 + g * 4];
#pragma unroll
    for (int ks = 0; ks < 8; ++ks) qc[ks] = *(const bf16x8*)(qbase + ks * 16);
    const bf16_t* kbase = P.kc + (size_t)(b * 2 + g) * 1024 * 128;
    const int kt1 = (t0 / 16 + 14) / 64 + 1;
    LAS float* lutl = (LAS float*)(lds + ABIAS);
#pragma unroll
    for (int i = 0; i < 4; ++i) lutl[tid + 512 * i] = P.lut2[(g * 4) * 512 + tid + 512 * i];
    u32x4 kreg[2];
#define IM_LOAD(kt) do { _Pragma("unroll") for (int p = 0; p < 2; ++p) { const int ci = tid + 512 * p; kreg[p] = *(const u32x4*)(kbase + (size_t)((kt) * 64 + (ci >> 4)) * 128 + (ci & 15) * 8); } } while (0)
#define IM_STORE(buf) do { _Pragma("unroll") for (int p = 0; p < 2; ++p) { const int ci = tid + 512 * p; const int key = ci >> 4, c = ci & 15; \
        *(LAS u32x4*)(lds + (buf) * AKT + key * 272 + c * 16) = kreg[p]; } } while (0)
    const int nh = (kt1 + 1) >> 1;
    const int kfirst = half ? nh : 0, klast = half ? kt1 : nh;
    if (kfirst >= klast) return;
    const int kbeg = half ? nh - 1 : 0;
    IM_LOAD(kbeg); IM_STORE(0); __syncthreads();
    const int kr0 = kappa32(r32);
    float carry = 0.f;
    float* irow = imp + ((size_t)(b * 2 + g) * S + t) * 256;
    for (int kt = kbeg; kt < klast; ++kt) {
        const int buf = (kt - kbeg) & 1;
        if (kt + 1 < klast) IM_LOAD(kt + 1);
        const int c0 = kt * 64;
        const bool farc = (qw0 - 16 * (c0 + 63) - 31) >= 127;
        if (!(16 * c0 > qw0)) {
            const LAS unsigned char* kb = lds + buf * AKT + kr0 * 272 + hi * 16;
            f32x16 ps0, ps1;
#pragma unroll
            for (int i = 0; i < 16; ++i) { ps0[i] = 0.f; ps1[i] = 0.f; }
#pragma unroll 1
            for (int hh = 0; hh < 4; ++hh) {
                f32x16 s0, s1; bf16x8 qf[8]; const float lseh = lsec;
#pragma unroll
                for (int ks = 0; ks < 8; ++ks) qf[ks] = qc[ks];
                { const int hn = (hh + 1) & 3; lsec = P.lse[gt * 8 + g * 4 + hn];
#pragma unroll
                  for (int ks = 0; ks < 8; ++ks) qc[ks] = *(const bf16x8*)(qbase + hn * 128 + ks * 16); }
#pragma unroll
                for (int i = 0; i < 16; ++i) { s0[i] = 0.f; s1[i] = 0.f; }
#pragma unroll
                for (int ks = 0; ks < 8; ++ks) {
                    const bf16x8 ka = *(const LAS bf16x8*)(kb + ks * 32); const bf16x8 kb2 = *(const LAS bf16x8*)(kb + ks * 32 + 32 * 272);
                    s0 = MFMA32(ka, qf[ks], s0); s1 = MFMA32(kb2, qf[ks], s1); }
                __builtin_amdgcn_sched_barrier(0);
                if (farc) { const float cc = lutl[hh * 512 + 511] - lseh;
#pragma unroll
                    for (int i = 0; i < 16; ++i) { ps0[i] += fexp2(s0[i] + cc); ps1[i] += fexp2(s1[i] + cc); }
                } else
#pragma unroll
                for (int i = 0; i < 16; ++i) { const int kl = 16 * (i >> 3) + 8 * hi + (i & 7);
                    const int d0 = t - 16 * (c0 + kl) - 31, d1 = d0 - 512;
                    const float e0 = s0[i] + lutl[hh * 512 + min(max(d0, 0), 511)] - lseh, e1 = s1[i] + lutl[hh * 512 + min(max(d1, 0), 511)] - lseh;
                    ps0[i] += d0 >= 0 ? fexp2(e0) : 0.f; ps1[i] += d1 >= 0 ? fexp2(e1) : 0.f; }
            }
            float plast[2][2];
            plast[0][0] = xh_partner(ps0[7], hi); plast[0][1] = xh_partner(ps0[15], hi); plast[1][0] = xh_partner(ps1[7], hi); plast[1][1] = xh_partner(ps1[15], hi);
#pragma unroll
            for (int s = 0; s < 2; ++s)
#pragma unroll
                for (int r = 0; r < 2; ++r) {
                    float pv[8];
#pragma unroll
                    for (int e = 0; e < 8; ++e) pv[e] = s ? ps1[8 * r + e] : ps0[8 * r + e];
                    const float prev = hi ? plast[s][r] : (r == 1 ? plast[s][0] : (s == 1 ? plast[0][1] : carry));
                    f32x2 o; o.x = (pv[0] + pv[1]) + (pv[2] + pv[3]) + prev; o.y = (pv[4] + pv[5]) + (pv[6] + pv[7]) + pv[3];
                    const int j0 = (c0 + 32 * s + 16 * r + 8 * hi) >> 2;
                    if (kt >= kfirst) *(f32x2*)(irow + j0) = o;
                }
            carry = plast[1][1];
        }
        if (kt + 1 < klast) IM_STORE(buf ^ 1);
        __syncthreads();
    }
#undef IM_LOAD
#undef IM_STORE
}

__device__ __forceinline__ void slc_prefetch(const AttnP& P, const float* imp, int b, int g, int t, int lane, f32x4& sc, u32x4 (&q)[4]) {
    const int col = lane & 15, qd = lane >> 4, head = g * 4 + (col & 3); const size_t gt = (size_t)b * S + t;
    sc = *(const f32x4*)(imp + ((size_t)(b * 2 + g) * S + t) * 256 + 4 * lane);
    const bf16_t* qp = P.proj + gt * NP + C_QN + head * 128 + 32 * qd;
#pragma unroll
    for (int ks = 0; ks < 4; ++ks) q[ks] = *(const u32x4*)(qp + 8 * ks);
}
__device__ __forceinline__ void slc_task(LAS unsigned char* lds, const AttnP& P, const float* imp, const bf16_t* vts, const bf16_t* kss, int b, int g, int t, int lane, const f32x4& sc_in, const u32x4 (&q_in)[4], bool dry = false) {
    const int col = lane & 15, qd = lane >> 4, hh = col & 3, head = g * 4 + hh;
    const size_t gt = (size_t)b * S + t; const int cur = t >> 6;
    const LAS float* lutl = (const LAS float*)(lds + ABIAS) + head * 512;
    f32x4 sc = sc_in;
#pragma unroll
    for (int e = 0; e < 4; ++e) { const int j = 4 * lane + e; sc[e] = (j > cur) ? -1.0f : ((j == 0 || j + 1 >= cur) ? 1e4f : sc[e]); }
    bool sl[4];
    if (cur + 1 <= 16) {
#pragma unroll
        for (int e2 = 0; e2 < 4; ++e2) sl[e2] = (4 * lane + e2) <= cur;
    } else {
        unsigned pref = 0u;
#pragma unroll 1
        for (int bit = 30; bit >= 0; --bit) {
            const float c = __uint_as_float(pref | (1u << bit));
            const int cnt = __popcll(__ballot(sc[0] >= c)) + __popcll(__ballot(sc[1] >= c)) + __popcll(__ballot(sc[2] >= c)) + __popcll(__ballot(sc[3] >= c));
            if (cnt >= 16) pref |= 1u << bit;
        }
        const float T = __uint_as_float(pref);
        const int cgt = __popcll(__ballot(sc[0] > T)) + __popcll(__ballot(sc[1] > T)) + __popcll(__ballot(sc[2] > T)) + __popcll(__ballot(sc[3] > T));
        const int need = 16 - cgt;
        int rk = 0;
#pragma unroll
        for (int e2 = 0; e2 < 4; ++e2) { const unsigned long long bt = __ballot(sc[e2] == T); rk += (int)__builtin_amdgcn_mbcnt_hi((unsigned)(bt >> 32), __builtin_amdgcn_mbcnt_lo((unsigned)bt, 0u)); }
#pragma unroll
        for (int e2 = 0; e2 < 4; ++e2) { const bool tie = sc[e2] == T; sl[e2] = (sc[e2] > T) || (tie && rk < need); rk += tie ? 1 : 0; }
    }
    const unsigned long long sb0 = __ballot(sl[0]), sb1 = __ballot(sl[1]), sb2 = __ballot(sl[2]), sb3 = __ballot(sl[3]);
    long qv[4];
    {
#pragma unroll
      for (int ks = 0; ks < 4; ++ks) { const u32x4 w = q_in[ks];
          unsigned lo = pk4_fp8(bflo(w.x) * 16.f, bfhi(w.x) * 16.f, bflo(w.y) * 16.f, bfhi(w.y) * 16.f), hi2 = pk4_fp8(bflo(w.z) * 16.f, bfhi(w.z) * 16.f, bflo(w.w) * 16.f, bfhi(w.w) * 16.f);
          if (col >= 4) { lo = 0u; hi2 = 0u; }
          qv[ks] = mk_i64(lo, hi2); } }
    float m_run = -1e30f, l_run = 0.f;
    const float c31 = lutl[511];
    f32x4 O[8];
#pragma unroll
    for (int dt = 0; dt < 8; ++dt) O[dt] = (f32x4){0.f, 0.f, 0.f, 0.f};
#pragma unroll 1
    for (int e4 = 0; e4 < 4; ++e4) {
      unsigned long long bal = e4 == 0 ? sb0 : e4 == 1 ? sb1 : e4 == 2 ? sb2 : sb3;
      while (bal) {
        const int j = __builtin_amdgcn_readfirstlane(4 * (int)__builtin_ctzll(bal) + e4); bal &= bal - 1;
        const unsigned char* kblk = (const unsigned char*)kss + ((size_t)(b * 2 + g) * 256 + j) * 8192 + lane * 16;
        const unsigned char* vblk = (const unsigned char*)vts + ((size_t)(b * 2 + g) * 256 + j) * 8192 + lane * 16;
        u32x4 kf[4][2], vf[8];
#pragma unroll
        for (int T = 0; T < 4; ++T)
#pragma unroll
            for (int p = 0; p < 2; ++p) kf[T][p] = *(const u32x4*)(kblk + (T * 2 + p) * 1024);
#pragma unroll
        for (int dt = 0; dt < 8; ++dt) vf[dt] = *(const u32x4*)(vblk + dt * 1024);
        f32x4 sT[4];
#pragma unroll
        for (int T = 0; T < 4; ++T) { sT[T] = (f32x4){0.f, 0.f, 0.f, 0.f};
#pragma unroll
            for (int p = 0; p < 2; ++p) { sT[T] = __builtin_amdgcn_mfma_f32_16x16x32_fp8_fp8(mk_i64(kf[T][p].x, kf[T][p].y), qv[2 * p], sT[T], 0, 0, 0);
                                          sT[T] = __builtin_amdgcn_mfma_f32_16x16x32_fp8_fp8(mk_i64(kf[T][p].z, kf[T][p].w), qv[2 * p + 1], sT[T], 0, 0, 0); } }
        float mx = -1e30f;
        if (t - (64 * j + 63) >= 127) {
#pragma unroll
            for (int T = 0; T < 4; ++T)
#pragma unroll
                for (int i = 0; i < 4; ++i) { const float a = sT[T][i] * 0.0625f + c31; sT[T][i] = a; mx = fmaxf(mx, a); }
        } else
#pragma unroll
        for (int T = 0; T < 4; ++T)
#pragma unroll
            for (int i = 0; i < 4; ++i) { const int kl = 32 * (T >> 1) + 8 * qd + 4 * (T & 1) + i; const int dist = t - (64 * j + kl);
                float a = sT[T][i] * 0.0625f + lutl[min(max(dist, 0), 511)]; a = dist >= 0 ? a : -1e30f; sT[T][i] = a; mx = fmaxf(mx, a); }
        mx = xr_max(xh_max(mx));
        const float m_new = fmaxf(m_run, mx); const float alpha = fexp2(m_run - m_new); m_run = m_new;
        float ls = 0.f;
#pragma unroll
        for (int T = 0; T < 4; ++T)
#pragma unroll
            for (int i = 0; i < 4; ++i) { float p = fexp2(sT[T][i] - m_new); p = sT[T][i] > -1e29f ? p : 0.f; sT[T][i] = p * 64.f; ls += p; }
        l_run = l_run * alpha + ls;
#pragma unroll
        for (int dt = 0; dt < 8; ++dt) O[dt] = O[dt] * alpha;
        long pb[2];
#pragma unroll
        for (int s = 0; s < 2; ++s) pb[s] = mk_i64(pk4_fp8(sT[2 * s][0], sT[2 * s][1], sT[2 * s][2], sT[2 * s][3]), pk4_fp8(sT[2 * s + 1][0], sT[2 * s + 1][1], sT[2 * s + 1][2], sT[2 * s + 1][3]));
#pragma unroll
        for (int dt = 0; dt < 8; ++dt) { O[dt] = __builtin_amdgcn_mfma_f32_16x16x32_fp8_fp8(mk_i64(vf[dt].x, vf[dt].y), pb[0], O[dt], 0, 0, 0);
                                         O[dt] = __builtin_amdgcn_mfma_f32_16x16x32_fp8_fp8(mk_i64(vf[dt].z, vf[dt].w), pb[1], O[dt], 0, 0, 0); }
      }
    }
    const float l_tot = xr_sum(xh_sum(l_run));
    float inv = l_tot > 0.f ? 0.015625f / l_tot : 0.f;
    inv *= sigmoidf_(P.small[gt * 32 + head * 3 + 1]);
    if (col < 4 && !dry) {
        const bf16_t* ocp = P.proj + gt * NP + C_VF + head * 128 + 4 * qd; const bf16_t* owp = P.ow + gt * 1024 + head * 128 + 4 * qd; bf16_t* yp = P.proj + gt * NP + C_QN + head * 128 + 4 * qd;
#pragma unroll
        for (int dt = 0; dt < 8; ++dt) { const u32x2 a = *(const u32x2*)(ocp + dt * 16), w = *(const u32x2*)(owp + dt * 16);
            u32x2 o; o.x = cvt_pk_bf16(O[dt][0] * inv + bflo(a.x) + bflo(w.x), O[dt][1] * inv + bfhi(a.x) + bfhi(w.x)); o.y = cvt_pk_bf16(O[dt][2] * inv + bflo(a.y) + bflo(w.y), O[dt][3] * inv + bfhi(a.y) + bfhi(w.y));
            *(u32x2*)(yp + dt * 16) = o; }
    }
}

#ifndef REP
#define REP -1
#endif
__device__ __forceinline__ void late_weights(LAS unsigned char* lds, const Args& a, int lane, int wid, int lw, int nlw, bf16_t* w_bn_t, bf16_t* w_bf_t, bf16_t* w_out_t, bf16_t* w_up_t, bf16_t* w_dn_t) {
    LAS float* scr = (LAS float*)(lds + wid * 16384);
    constexpr int I_BN = 16 * 64, I_OUT = 32 * 64, I_UP = 32 * 352, I_DN = 88 * 64;
    constexpr int NITEMS = 2 * I_BN + I_OUT + I_UP + I_DN;
    for (int it = lw; it < NITEMS; it += nlw) {
        int r = it;
        if (r < I_BN) { transpose_item(a.w_bn, 2048, 1024, w_bn_t, 1024, 64 * (r / 64), 32 * (r % 64), MapId{2048}, scr, lane); continue; } r -= I_BN;
        if (r < I_BN) { transpose_item(a.w_bf, 2048, 1024, w_bf_t, 1024, 64 * (r / 64), 32 * (r % 64), MapId{2048}, scr, lane); continue; } r -= I_BN;
        if (r < I_OUT) { transpose_item(a.w_out, 2048, 2048, w_out_t, 2048, 64 * (r / 64), 32 * (r % 64), MapId{2048}, scr, lane); continue; } r -= I_OUT;
        if (r < I_UP) { transpose_item(a.w_up, NUP, 2048, w_up_t, 2048, 64 * (r / 352), 32 * (r % 352), MapUp{}, scr, lane); continue; } r -= I_UP;
        transpose_item(a.w_down, 2048, DFF, w_dn_t, DFF, 64 * (r / 64), 32 * (r % 64), MapId{2048}, scr, lane);
    }
}
__device__ __forceinline__ void phase0(LAS unsigned char* lds, const Args& a, int wid, int G, int bx, int gw, int NGW,
    bf16_t* w_in_t, bf16_t* w_bn_t, bf16_t* w_bf_t, bf16_t* w_out_t, bf16_t* w_up_t, bf16_t* w_dn_t, bf16_t* w1k_t, bf16_t* w1v_t, bf16_t* w2k_t, bf16_t* w2v_t, float* c1k, float* c1v, float* lut2,
    bf16_t* hbuf, bf16_t* proj, bf16_t* vtf, float* small, float* cum2, bf16_t* vtw, bf16_t* vts, bf16_t* kcn, bf16_t* vcn, bf16_t* kss) {
    const int lane = lane_id(), tid = wid * 64 + lane; (void)tid;
        LAS float* scr = (LAS float*)(lds + wid * 16384);
        constexpr int I_IN = 32 * 312, I_W1 = 64 * 8, I_W2 = 4 * 8;
        constexpr int NITEMS = I_IN + 2 * I_W1 + 2 * I_W2;
        for (int it = gw; it < NITEMS; it += NGW) {
            int r = it;
            if (r < I_IN) { transpose_item(a.w_in, 9760, 2048, w_in_t, 2048, 64 * (r / 312), 32 * (r % 312), MapIn{}, scr, lane); continue; } r -= I_IN;
            if (r < I_W1) { transpose_item(a.w1_k, 128, 4096, w1k_t, 4096, 64 * (r / 8), 32 * (r % 8), MapId{128}, scr, lane); continue; } r -= I_W1;
            if (r < I_W1) { transpose_item(a.w1_v, 128, 4096, w1v_t, 4096, 64 * (r / 8), 32 * (r % 8), MapId{128}, scr, lane); continue; } r -= I_W1;
            if (r < I_W2) { transpose_item(a.w2_k, 128, 128, w2k_t, 256, 64 * (r / 8), 32 * (r % 8), MapId{128}, scr, lane); continue; } r -= I_W2;
            transpose_item(a.w2_v, 128, 128, w2v_t, 256, 64 * (r / 8), 32 * (r % 8), MapId{128}, scr, lane);
        }
        for (int m = gw; m < MT; m += NGW) rms_row_bf16(a.x + (size_t)m * DM, a.attn_g, hbuf + (size_t)m * DM, lane);
        for (int it = gw; it < 512; it += NGW) {
            const int which = it >> 8, n = it & 255; const float* pos = which ? a.pos_v : a.pos_k; const float* w1 = which ? a.w1_v : a.w1_k; float s = 0.f;
            if (n < 128) { float s4[8] = {0.f, 0.f, 0.f, 0.f, 0.f, 0.f, 0.f, 0.f};
#pragma unroll 1
                for (int k = lane; k < 4096; k += 512) {
#pragma unroll
                    for (int e = 0; e < 8; ++e) s4[e] += pos[k + 64 * e] * w1[(size_t)(k + 64 * e) * 128 + n]; }
                s = ((s4[0] + s4[1]) + (s4[2] + s4[3])) + ((s4[4] + s4[5]) + (s4[6] + s4[7])); }
            s = wave_sum(s); if (lane == 0) (which ? c1v : c1k)[n] = s;
        }
        for (int i = gw * 64 + lane; i < 4096; i += NGW * 64) {
            const int head = i >> 9, n = i & 511; int bk;
            if (n < 16) bk = n; else { const int lg = 16 + (int)(logf((float)n / 16.0f) / logf(8.0f) * 16.0f); bk = lg < 31 ? lg : 31; }
            lut2[i] = a.rel[bk * 8 + head] * LOG2E;
        }
    }

__device__ __forceinline__ void phase2(LAS unsigned char* lds, const Args& a, int wid, int G, int bx, int gw, int NGW,
    bf16_t* w_in_t, bf16_t* w_bn_t, bf16_t* w_bf_t, bf16_t* w_out_t, bf16_t* w_up_t, bf16_t* w_dn_t, bf16_t* w1k_t, bf16_t* w1v_t, bf16_t* w2k_t, bf16_t* w2v_t, float* c1k, float* c1v, float* lut2,
    bf16_t* hbuf, bf16_t* proj, bf16_t* vtf, float* small, float* cum2, bf16_t* vtw, bf16_t* vts, bf16_t* kcn, bf16_t* vcn, bf16_t* kss) {
    const int lane = lane_id(), tid = wid * 64 + lane; (void)tid;
        if (bx < 16) {
            const int b = bx >> 3, h = bx & 7; const float fb = a.fbias[h]; float loc[32]; float run = 0.f;
#pragma unroll
            for (int i = 0; i < 32; ++i) { const float xx = small[((size_t)b * S + tid * 32 + i) * 32 + 24 + h] + fb;
                const float ls = xx >= 0.f ? -log1pf(expf(-xx)) : xx - log1pf(expf(xx)); run += ls; loc[i] = run; }
            float inc = run;
#pragma unroll
            for (int o = 1; o < 64; o <<= 1) { const float nb = __shfl_up(inc, o); if (lane >= o) inc += nb; }
            LAS float* wt = (LAS float*)(lds + 140000);
            if (lane == 63) wt[wid] = inc;
            __syncthreads();
            float off = inc - run;
            for (int w = 0; w < wid; ++w) off += wt[w];
#pragma unroll
            for (int i = 0; i < 32; ++i) cum2[(size_t)(b * 8 + h) * S + tid * 32 + i] = (off + loc[i]) * LOG2E;
            __syncthreads();
        }
        if (bx == 16) { bf16_t* padp = ((tid < 256) ? kcn : vcn) + (size_t)4 * S * 128 + (tid & 255) * 8; *(u32x4*)padp = (u32x4){0u, 0u, 0u, 0u}; }
        LAS unsigned char* scr = lds + wid * 17408;
        constexpr int NTR = 4096 + 1024 + 1024 + 1024;
        for (int it = gw; it < NTR; it += NGW) {
            int seq, tile, col0, kind; bf16_t* dst; int b;
            if (it < 4096) { seq = it >> 8; tile = it & 255; b = seq >> 3; col0 = C_VF + (seq & 7) * 128; dst = vtf; kind = 0; }
            else if (it < 5120) { const int r = it - 4096; seq = r >> 8; tile = r & 255; b = seq >> 1; col0 = C_VW + (seq & 1) * 128; dst = vtw; kind = 0; }
            else if (it < 6144) { const int r = it - 5120; seq = r >> 8; tile = r & 255; b = seq >> 1; col0 = C_VS + (seq & 1) * 128; dst = vts; kind = 1; }
            else { const int r = it - 6144; seq = r >> 8; tile = r & 255; b = seq >> 1; col0 = C_KS + (seq & 1) * 128; dst = kss; kind = 2; }
            const bf16_t* src = proj + ((size_t)b * S + tile * 64) * NP + col0;
#pragma unroll
            for (int i = 0; i < 16; ++i) { const int row = 4 * i + (lane >> 4), ch = lane & 15; *(LAS u32x4*)(scr + row * 272 + ch * 16) = *(const u32x4*)(src + (size_t)row * NP + ch * 8); }
            asm volatile("s_waitcnt lgkmcnt(0)" ::: "memory");
            bf16_t* dblk = dst + ((size_t)seq * 256 + tile) * 8192;
            if (kind == 0) {
#pragma unroll 2
                for (int i = 0; i < 16; ++i) { const int oc = i * 64 + lane, d = oc >> 3, tc = oc & 7; const LAS unsigned short* sp = (const LAS unsigned short*)(scr + (8 * tc) * 272 + d * 2);
                    u32x4 o; o.x = (unsigned)sp[0] | ((unsigned)sp[136] << 16); o.y = (unsigned)sp[272] | ((unsigned)sp[408] << 16); o.z = (unsigned)sp[544] | ((unsigned)sp[680] << 16); o.w = (unsigned)sp[816] | ((unsigned)sp[952] << 16);
                    *(u32x4*)(dblk + d * 64 + 8 * tc) = o; }
            } else if (kind == 1) {
                unsigned char* d8 = (unsigned char*)dst + ((size_t)seq * 256 + tile) * 8192;
#pragma unroll 2
                for (int dt = 0; dt < 8; ++dt) { const int qd = lane >> 4, r = lane & 15; const LAS unsigned short* sp = (const LAS unsigned short*)(scr + (8 * qd) * 272 + (16 * dt + r) * 2);
                    float f[16];
#pragma unroll
                    for (int e = 0; e < 8; ++e) { f[e] = __uint_as_float((unsigned)sp[136 * e] << 16); f[8 + e] = __uint_as_float((unsigned)sp[136 * (32 + e)] << 16); }
                    u32x4 o; o.x = pk4_fp8(f[0], f[1], f[2], f[3]); o.y = pk4_fp8(f[4], f[5], f[6], f[7]); o.z = pk4_fp8(f[8], f[9], f[10], f[11]); o.w = pk4_fp8(f[12], f[13], f[14], f[15]);
                    *(u32x4*)(d8 + (dt * 64 + lane) * 16) = o; }
            } else {
                unsigned char* d8 = (unsigned char*)dst + ((size_t)seq * 256 + tile) * 8192;
#pragma unroll 2
                for (int i = 0; i < 8; ++i) { const int T = i >> 1, p = i & 1, kq = lane >> 4, r = lane & 15; const int key = 32 * (T >> 1) + 8 * (r >> 2) + 4 * (T & 1) + (r & 3);
                    const u32x4 lo = *(const LAS u32x4*)(scr + key * 272 + (32 * kq + 16 * p) * 2), hi = *(const LAS u32x4*)(scr + key * 272 + (32 * kq + 16 * p) * 2 + 16);
                    u32x4 o; o.x = pk4_fp8(bflo(lo.x), bfhi(lo.x), bflo(lo.y), bfhi(lo.y)); o.y = pk4_fp8(bflo(lo.z), bfhi(lo.z), bflo(lo.w), bfhi(lo.w));
                    o.z = pk4_fp8(bflo(hi.x), bfhi(hi.x), bflo(hi.y), bfhi(hi.y)); o.w = pk4_fp8(bflo(hi.z), bfhi(hi.z), bflo(hi.w), bfhi(hi.w));
                    *(u32x4*)(d8 + (i * 64 + lane) * 16) = o; }
            }
            asm volatile("s_waitcnt lgkmcnt(0)" ::: "memory");
        }
        {
            const int b = gw & 1, w2 = gw >> 1, NW2 = NGW >> 1; float mxn = 0.f;
            for (int tk = w2; tk < S; tk += NW2) { const bf16_t* kp = proj + ((size_t)b * S + tk) * NP + C_KF + lane * 16; const u32x4 v0 = *(const u32x4*)kp, v1 = *(const u32x4*)(kp + 8);
                float ss = bflo(v0.x) * bflo(v0.x) + bfhi(v0.x) * bfhi(v0.x) + bflo(v0.y) * bflo(v0.y) + bfhi(v0.y) * bfhi(v0.y) + bflo(v0.z) * bflo(v0.z) + bfhi(v0.z) * bfhi(v0.z) + bflo(v0.w) * bflo(v0.w) + bfhi(v0.w) * bfhi(v0.w)
                         + bflo(v1.x) * bflo(v1.x) + bfhi(v1.x) * bfhi(v1.x) + bflo(v1.y) * bflo(v1.y) + bfhi(v1.y) * bfhi(v1.y) + bflo(v1.z) * bflo(v1.z) + bfhi(v1.z) * bfhi(v1.z) + bflo(v1.w) * bflo(v1.w) + bfhi(v1.w) * bfhi(v1.w);
                ss += __shfl_xor(ss, 1); ss += __shfl_xor(ss, 2); ss += __shfl_xor(ss, 4); mxn = fmaxf(mxn, ss); }
            if ((lane & 7) == 0) atomicMax((unsigned*)(a.ws + 12288) + b * 8 + (lane >> 3), __float_as_uint(mxn));
        }
        for (int it0 = gw; it0 < 2 * 4 * (S / 4); it0 += 4 * NGW) {
            u32x4 v[4]; size_t dsto[4]; int wh[4];
#pragma unroll
            for (int e = 0; e < 4; ++e) { const int it = it0 + e * NGW; const int which = it / (4 * (S / 4)), r = it % (4 * (S / 4)), seq = r / (S / 4), t4 = r % (S / 4); const int b = seq >> 1, g = seq & 1;
                const int tok = t4 * 4 + (lane >> 4), ch = lane & 15; wh[e] = which; dsto[e] = ((size_t)seq * S + tok) * 128 + ch * 8;
                v[e] = *(const u32x4*)(proj + ((size_t)b * S + tok) * NP + (which ? C_VC : C_KC) + g * 128 + ch * 8); }
#pragma unroll
            for (int e = 0; e < 4; ++e) *(u32x4*)((wh[e] ? vcn : kcn) + dsto[e]) = v[e];
        }
    }

__global__ void __launch_bounds__(512, 2) fwd_kernel(Args a) {
    extern __shared__ __attribute__((aligned(16))) unsigned char lds_raw[];
    LAS unsigned char* lds = (LAS unsigned char*)lds_raw;
    cg::grid_group grid = cg::this_grid();
    const int wid = __builtin_amdgcn_readfirstlane(threadIdx.x >> 6);
    const int G = gridDim.x, bx = blockIdx.x;
    const int vcu = (G % 8 == 0) ? (bx % 8) * (G / 8) + bx / 8 : bx;
    const int gw = vcu * 8 + wid, NGW = G * 8;
    unsigned char* ws = a.ws; unsigned char* dob = (unsigned char*)a.out;
    bf16_t* w_in_t = (bf16_t*)(ws + WS_WIN); bf16_t* w_bn_t = (bf16_t*)(ws + WS_WBN); bf16_t* w_bf_t = (bf16_t*)(ws + WS_WBF); bf16_t* w_out_t = (bf16_t*)(ws + WS_WOUT);
    bf16_t* w_up_t = (bf16_t*)(ws + WS_WUP); bf16_t* w_dn_t = (bf16_t*)(ws + WS_WDN); bf16_t* w1k_t = (bf16_t*)(ws + WS_W1K); bf16_t* w1v_t = (bf16_t*)(ws + WS_W1V);
    bf16_t* w2k_t = (bf16_t*)(ws + WS_W2K); bf16_t* w2v_t = (bf16_t*)(ws + WS_W2V);
    float* c1k = (float*)(ws + WS_MISC); float* c1v = c1k + 256; float* lut2 = c1k + 1024;
    bf16_t* hbuf = (bf16_t*)(ws + WS_H); bf16_t* proj = (bf16_t*)(ws + WS_PROJ); bf16_t* vtf = (bf16_t*)(ws + WS_VTF);
    float* small = (float*)(ws + WS_SMALL); float* cum2 = (float*)(ws + WS_CUM); float* lse = (float*)(ws + WS_LSE);
    bf16_t* kc = (bf16_t*)(ws + WS_KC); bf16_t* vct = (bf16_t*)(ws + WS_VCT); bf16_t* tmpk = (bf16_t*)(ws + WS_TMPK); bf16_t* tmpv = (bf16_t*)(ws + WS_TMPV);
    bf16_t* uv = (bf16_t*)(ws + WS_UV);
    bf16_t* ow = (bf16_t*)(dob + DO_OW); float* imp = (float*)(dob + DO_IMP); bf16_t* vtw = (bf16_t*)(dob + DO_VTW); bf16_t* vts = (bf16_t*)(dob + DO_VTS);
    bf16_t* kcn = (bf16_t*)(dob + DO_KCN); bf16_t* vcn = (bf16_t*)(dob + DO_VCN); bf16_t* kss = (bf16_t*)(dob + DO_KSS);

    PH(0) { phase0(lds, a, wid, G, bx, gw, NGW, w_in_t, w_bn_t, w_bf_t, w_out_t, w_up_t, w_dn_t, w1k_t, w1v_t, w2k_t, w2v_t, c1k, c1v, lut2, hbuf, proj, vtf, small, cum2, vtw, vts, kcn, vcn, kss); }
#if REP == 0
    { phase0(lds, a, wid, G, bx, gw, NGW, w_in_t, w_bn_t, w_bf_t, w_out_t, w_up_t, w_dn_t, w1k_t, w1v_t, w2k_t, w2v_t, c1k, c1v, lut2, hbuf, proj, vtf, small, cum2, vtw, vts, kcn, vcn, kss); }
#endif
    grid.sync();
#if 0
    grid_bar((unsigned*)ws + 64 * 1, (unsigned)G, wid);
#endif
    PH(1) { pg8::Gemm g{hbuf, w_in_t, DM, DM, DM}; pg8::StaticOrder So; So.init(MT, NP, G, bx); pg8::EpiInProj E{proj, small}; pg8::gemm_phase(lds, g, So, E, wid); }
#if REP == 1
    { pg8::Gemm g{hbuf, w_in_t, DM, DM, DM}; pg8::StaticOrder So; So.init(MT, NP, G, bx); pg8::EpiInProj E{proj, small}; pg8::gemm_phase(lds, g, So, E, wid); }
#endif
    grid_bar((unsigned*)ws + 64 * 2, (unsigned)G, wid);
#if 0
    grid_bar((unsigned*)ws + 64 * 3, (unsigned)G, wid);
#endif
    PH(2) { phase2(lds, a, wid, G, bx, gw, NGW, w_in_t, w_bn_t, w_bf_t, w_out_t, w_up_t, w_dn_t, w1k_t, w1v_t, w2k_t, w2v_t, c1k, c1v, lut2, hbuf, proj, vtf, small, cum2, vtw, vts, kcn, vcn, kss); }
#if REP == 2
    { phase2(lds, a, wid, G, bx, gw, NGW, w_in_t, w_bn_t, w_bf_t, w_out_t, w_up_t, w_dn_t, w1k_t, w1v_t, w2k_t, w2v_t, c1k, c1v, lut2, hbuf, proj, vtf, small, cum2, vtw, vts, kcn, vcn, kss); }
#endif
    grid_bar((unsigned*)ws + 64 * 4, (unsigned)G, wid);
#if 0
    grid_bar((unsigned*)ws + 64 * 5, (unsigned)G, wid);
#endif
    PH(3) {
        pg8::StaticOrder So; So.init(4096, 256, G / 2, bx >> 1);
        if (bx >= 32) late_weights(lds, a, lane_id(), wid, (bx - 32) * 8 + wid, (G - 32) * 8, w_bn_t, w_bf_t, w_out_t, w_up_t, w_dn_t);
        else if ((bx & 1) == 0) { { pg8::Gemm g{kcn, w1k_t, 2048, 4096, 4096}; pg8::EpiBf16<1> E{tmpk, 256, c1k}; pg8::gemm_phase(lds, g, So, E, wid); }
            asm volatile("s_waitcnt vmcnt(0)" ::: "memory"); __syncthreads();
            { pg8::Gemm g{tmpk, w2k_t, 256, 256, 256}; pg8::EpiCmp2<false> E{kc}; pg8::gemm_phase(lds, g, So, E, wid); } }
        else { { pg8::Gemm g{vcn, w1v_t, 2048, 4096, 4096}; pg8::EpiBf16<1> E{tmpv, 256, c1v}; pg8::gemm_phase(lds, g, So, E, wid); }
            asm volatile("s_waitcnt vmcnt(0)" ::: "memory"); __syncthreads();
            { pg8::Gemm g{tmpv, w2v_t, 256, 256, 256}; pg8::EpiCmp2<true> E{vct}; pg8::gemm_phase(lds, g, So, E, wid); } }
    }
#if REP == 3
    {
        pg8::StaticOrder So; So.init(4096, 256, G / 2, bx >> 1);
        if ((bx & 1) == 0) { pg8::Gemm g{kcn, w1k_t, 2048, 4096, 4096}; pg8::EpiBf16<1> E{tmpk, 256, c1k}; pg8::gemm_phase(lds, g, So, E, wid); }
        else { pg8::Gemm g{vcn, w1v_t, 2048, 4096, 4096}; pg8::EpiBf16<1> E{tmpv, 256, c1v}; pg8::gemm_phase(lds, g, So, E, wid); }
    }
#endif
    grid_bar((unsigned*)ws + 64 * 6, (unsigned)G, wid);
#if 0
    grid_bar((unsigned*)ws + 64 * 7, (unsigned)G, wid);
#endif
    const AttnP AP{proj, kc, vtf, vtw, vct, cum2, lut2, small, ow, lse, (const float*)(ws + 12288)};
    PH(5) {
#ifndef ATM
#define ATM 7
#endif
        if (a.probe == 5) for (int q = vcu * 4; q < 1024; q += G * 4)
#pragma unroll 1
            for (int i = 0; i < 4; ++i) { const int pp = (q + i) >> 1; if (pp >= 512) break; const int bh = pp >> 5, s = pp & 31;
                attn_unit<0>(lds, AP, bh >> 3, bh & 7, (i & 1) ? s : 63 - s, wid, true); }
        {
            unsigned* qctr = (unsigned*)(ws + 12544);
            LAS int* qslot = (LAS int*)(lds + ABIAS + 20480);
#pragma unroll 1
            for (;;) {
                if (wid == 0 && lane_id() == 0) *qslot = (int)atomicAdd(qctr, 1u);
                __syncthreads();
                const int q = __builtin_amdgcn_readfirstlane(*qslot);
                __syncthreads();
                if (q >= 3072) break;
                if (q < 1024) { const int bh = q >> 6; attn_unit<0>(lds, AP, bh >> 3, bh & 7, 63 - (q & 63), wid); }
                else if (q < 2048) { const int u = q - 1024, bg = u >> 8; attn_unit<1>(lds, AP, bg >> 1, bg & 1, 255 - (u & 255), wid); }
                else { const int u = q - 2048, bh = u & 15; attn_unit<2>(lds, AP, bh >> 3, bh & 7, 63 - (u >> 4), wid); }
            }
        }
    }
    grid_bar((unsigned*)ws + 64 * 10, (unsigned)G, wid);
#if 0
    grid_bar((unsigned*)ws + 64 * 11, (unsigned)G, wid);
#endif
    PH(6) for (int uu = vcu; uu < 256; uu += G) for (int e2 = 0; e2 < 2; ++e2) { const int u = e2 ? 511 - uu : uu; const int qb = 63 - (u >> 3), rest = u & 7; imp_unit(lds, AP, imp, rest >> 2, (rest >> 1) & 1, qb, rest & 1, wid); }
#if REP == 6
    for (int uu = vcu; uu < 256; uu += G) for (int e2 = 0; e2 < 2; ++e2) { const int u = e2 ? 511 - uu : uu; const int qb = 63 - (u >> 3), rest = u & 7; imp_unit(lds, AP, imp, rest >> 2, (rest >> 1) & 1, qb, rest & 1, wid); }
#endif
    grid_bar((unsigned*)ws + 64 * 12, (unsigned)G, wid);
#if 0
    grid_bar((unsigned*)ws + 64 * 13, (unsigned)G, wid);
#endif
    PH(7) {
        LAS float* lutl = (LAS float*)(lds + ABIAS);
#pragma unroll
        for (int i = 0; i < 8; ++i) { const int tid = wid * 64 + lane_id(); lutl[tid + 512 * i] = lut2[tid + 512 * i]; }
        __syncthreads();
        const int ntask = NB * 2 * S;
        if (G == 256) {
            const int xcd = bx & 7, lb = bx >> 3, bg = xcd >> 1, tb = (xcd & 1) * 8192;
            if (a.probe == 7) for (int r = 0; r < 32; ++r) { f32x4 sc; u32x4 q[4]; const int ln = lane_id(); slc_prefetch(AP, imp, bg >> 1, bg & 1, tb + r * 256 + lb * 8 + wid, ln, sc, q);
                slc_task(lds, AP, imp, vts, kss, bg >> 1, bg & 1, tb + r * 256 + lb * 8 + wid, ln, sc, q, true); }
            { f32x4 sc; u32x4 q[4]; const int ln = lane_id();
              slc_prefetch(AP, imp, bg >> 1, bg & 1, tb + lb * 8 + wid, ln, sc, q);
#pragma unroll 1
              for (int r = 0; r < 32; ++r) { f32x4 scn = sc; u32x4 qn[4] = {q[0], q[1], q[2], q[3]};
                  if (r + 1 < 32) slc_prefetch(AP, imp, bg >> 1, bg & 1, tb + (r + 1) * 256 + lb * 8 + wid, ln, scn, qn);
                  slc_task(lds, AP, imp, vts, kss, bg >> 1, bg & 1, tb + r * 256 + lb * 8 + wid, ln, sc, q);
                  sc = scn; q[0] = qn[0]; q[1] = qn[1]; q[2] = qn[2]; q[3] = qn[3]; } }
        } else {
            for (int task = gw; task < ntask; task += NGW) { const int bg = task / S; f32x4 sc; u32x4 q[4]; const int ln = lane_id(); slc_prefetch(AP, imp, bg >> 1, bg & 1, task % S, ln, sc, q); slc_task(lds, AP, imp, vts, kss, bg >> 1, bg & 1, task % S, ln, sc, q); }
        }
    }
    grid_bar((unsigned*)ws + 64 * 14, (unsigned)G, wid);
#if 0
    grid_bar((unsigned*)ws + 64 * 15, (unsigned)G, wid);
#endif
    PH(8) {
        pg8::StaticOrder So; So.init(MT, DM, G, bx);
        { pg8::Gemm g{proj + C_QN, w_bn_t, NP, 1024, 1024}; pg8::EpiMerge<false> E{proj + C_MA, hbuf}; pg8::gemm_phase(lds, g, So, E, wid); }
        { pg8::Gemm g{proj + C_QF, w_bf_t, NP, 1024, 1024}; pg8::EpiMerge<true> E{proj + C_MB, hbuf}; pg8::gemm_phase(lds, g, So, E, wid); }
    }
#if REP == 8
    {
        pg8::StaticOrder So; So.init(MT, DM, G, bx);
        { pg8::Gemm g{proj + C_QN, w_bn_t, NP, 1024, 1024}; pg8::EpiMerge<false> E{proj + C_MA, hbuf}; pg8::gemm_phase(lds, g, So, E, wid); }
        { pg8::Gemm g{proj + C_QF, w_bf_t, NP, 1024, 1024}; pg8::EpiMerge<true> E{proj + C_MB, hbuf}; pg8::gemm_phase(lds, g, So, E, wid); }
    }
#endif
    grid_bar((unsigned*)ws + 64 * 16, (unsigned)G, wid);
#if 0
    grid_bar((unsigned*)ws + 64 * 17, (unsigned)G, wid);
#endif
#ifndef FUSE9
#define FUSE9 1
#endif
#ifndef FUSE13
#define FUSE13 1
#endif
    constexpr bool fused9 = FUSE9, fused13 = FUSE13;
    PH(9) { pg8::Gemm g{hbuf, w_out_t, DM, DM, DM}; pg8::StaticOrder So;
#if FUSE9
        So.init(MT, DM, G, bx, 4); pg8::EpiOutNorm E{a.x, a.out, hbuf, a.ffn_g, pg8::RowStats{(unsigned*)(ws + 957 * MiB), (unsigned*)(ws + 16384)}}; pg8::gemm_phase(lds, g, So, E, wid); }
#else
        So.init(MT, DM, G, bx); pg8::EpiResid E{a.x, a.out, false}; pg8::gemm_phase(lds, g, So, E, wid); }
#endif
#if REP == 9
    { pg8::Gemm g{hbuf, w_out_t, DM, DM, DM}; pg8::StaticOrder So; So.init(MT, DM, G, bx); pg8::EpiResid E{a.x, a.out, false}; pg8::gemm_phase(lds, g, So, E, wid); }
#endif
    grid_bar((unsigned*)ws + 64 * 18, (unsigned)G, wid);
#if 0
    grid_bar((unsigned*)ws + 64 * 19, (unsigned)G, wid);
#endif
    PH(10) if (!fused9) for (int m = gw; m < MT; m += NGW) rms_row_bf16(a.out + (size_t)m * DM, a.ffn_g, hbuf + (size_t)m * DM, lane_id());
#if REP == 10
    for (int m = gw; m < MT; m += NGW) rms_row_bf16(a.out + (size_t)m * DM, a.ffn_g, hbuf + (size_t)m * DM, lane_id());
#endif
    if (!fused9) grid_bar((unsigned*)ws + 64 * 20, (unsigned)G, wid);
#if 0
    grid_bar((unsigned*)ws + 64 * 21, (unsigned)G, wid);
#endif
    PH(11) { pg8::Gemm g{hbuf, w_up_t, DM, DM, DM}; pg8::StaticOrder So; So.init(MT, NUP, G, bx); pg8::EpiUpAct E{(bf16_t*)(ws + WS_ACT), (float*)(ws + WS_SU), (float*)(ws + WS_SV), a.conv_w, a.conv_b}; pg8::gemm_phase(lds, g, So, E, wid); }
#if REP == 11
    { pg8::Gemm g{hbuf, w_up_t, DM, DM, DM}; pg8::StaticOrder So; So.init(MT, NUP, G, bx); pg8::EpiUpAct E{(bf16_t*)(ws + WS_ACT), (float*)(ws + WS_SU), (float*)(ws + WS_SV), a.conv_w, a.conv_b}; pg8::gemm_phase(lds, g, So, E, wid); }
#endif
    grid_bar((unsigned*)ws + 64 * 22, (unsigned)G, wid);
#if 0
    grid_bar((unsigned*)ws + 64 * 23, (unsigned)G, wid);
#endif
    PH(12) {
        float* SU = (float*)(ws + WS_SU); float* SV = (float*)(ws + WS_SV); bf16_t* actb = (bf16_t*)(ws + WS_ACT);
        constexpr int NCG = DFF / 4;
        for (int it = bx * 512 + wid * 64 + lane_id(); it < 512 * NCG; it += G * 512) {
            const int grp = it / NCG, j0 = (it % NCG) * 4; const bool first = (grp & 255) == 0;
            const f32x4 w0 = *(const f32x4*)(a.conv_w + j0), w1 = *(const f32x4*)(a.conv_w + DFF + j0), w2 = *(const f32x4*)(a.conv_w + 2 * DFF + j0), cb = *(const f32x4*)(a.conv_b + j0);
            const float* su = SU + (size_t)grp * 4 * DFF + j0;
            f32x4 um2 = (f32x4){0.f, 0.f, 0.f, 0.f}, um1 = um2;
            if (!first) { um2 = *(const f32x4*)su; um1 = *(const f32x4*)(su + DFF); }
            const f32x4 u0 = *(const f32x4*)(su + 2 * DFF), u1 = *(const f32x4*)(su + 3 * DFF);
            const f32x4 v0 = *(const f32x4*)(SV + (size_t)grp * 2 * DFF + j0), v1 = *(const f32x4*)(SV + ((size_t)grp * 2 + 1) * DFF + j0);
            f32x4 o0, o1;
#pragma unroll
            for (int i = 0; i < 4; ++i) { o0[i] = gelu_tanh(cb[i] + w0[i] * um2[i] + w1[i] * um1[i] + w2[i] * u0[i]) * v0[i]; o1[i] = gelu_tanh(cb[i] + w0[i] * um1[i] + w1[i] * u0[i] + w2[i] * u1[i]) * v1[i]; }
            u32x2 p0, p1; p0.x = cvt_pk_bf16(o0[0], o0[1]); p0.y = cvt_pk_bf16(o0[2], o0[3]); p1.x = cvt_pk_bf16(o1[0], o1[1]); p1.y = cvt_pk_bf16(o1[2], o1[3]);
            *(u32x2*)(actb + (size_t)(grp * 64) * DFF + j0) = p0; *(u32x2*)(actb + (size_t)(grp * 64 + 1) * DFF + j0) = p1;
        }
    }
    grid_bar((unsigned*)ws + 64 * 24, (unsigned)G, wid);
#if 0
    grid_bar((unsigned*)ws + 64 * 25, (unsigned)G, wid);
#endif
#if REP == 13
    { pg8::Gemm g{(const bf16_t*)(ws + WS_ACT), w_dn_t, DFF, DFF, DFF}; pg8::StaticOrder So; So.init(MT, DM, G, bx); pg8::EpiResid E{a.out, a.out, a.probe == 0}; pg8::gemm_phase(lds, g, So, E, wid); }
#endif
    PH(13) { pg8::Gemm g{(const bf16_t*)(ws + WS_ACT), w_dn_t, DFF, DFF, DFF}; pg8::StaticOrder So;
#if FUSE13
        So.init(MT, DM, G, bx, 4); pg8::EpiFinalNorm E{a.out, a.final_g, pg8::RowStats{(unsigned*)(ws + 958 * MiB), (unsigned*)(ws + 16384 + 32768)}}; pg8::gemm_phase(lds, g, So, E, wid); }
#else
        So.init(MT, DM, G, bx); pg8::EpiResid E{a.out, a.out, false}; pg8::gemm_phase(lds, g, So, E, wid); }
#endif
    if (!fused13) grid_bar((unsigned*)ws + 64 * 26, (unsigned)G, wid);
#if 0
    grid_bar((unsigned*)ws + 64 * 27, (unsigned)G, wid);
#endif
    PH(14) if (!fused13) for (int m = gw; m < MT; m += NGW) rms_row_f32_inplace(a.out + (size_t)m * DM, a.final_g, lane_id());
}

extern "C" void kernel_launch(void* const* d_in, const int* in_sizes, int n_in, void* d_out, int out_size, void* d_ws, size_t ws_size, hipStream_t stream) {
    static int grid = 0;
    if (grid == 0) {
        if (n_in != 20 || out_size != MT * DM || ws_size < WS_END) { fprintf(stderr, "kernel_launch: unexpected shapes (n_in %d out %d ws %zu)\n", n_in, out_size, ws_size); grid = -1; return; }
        int dev = 0, cus = 0, per_cu = 0;
        (void)hipGetDevice(&dev); (void)hipDeviceGetAttribute(&cus, hipDeviceAttributeMultiprocessorCount, dev);
        if (hipFuncSetAttribute((const void*)fwd_kernel, hipFuncAttributeMaxDynamicSharedMemorySize, LDS_BYTES) != hipSuccess) { fprintf(stderr, "kernel_launch: hipFuncSetAttribute failed\n"); grid = -1; return; }
        if (hipOccupancyMaxActiveBlocksPerMultiprocessor(&per_cu, (const void*)fwd_kernel, 512, LDS_BYTES) != hipSuccess || per_cu < 1) { fprintf(stderr, "kernel_launch: occupancy query says %d\n", per_cu); per_cu = 1; }
        (void)hipGetLastError();
        grid = cus * 1;
        if (grid != 256) { fprintf(stderr, "kernel_launch: built for a 256-CU device (fused-norm epilogues pair the 8 owners of a row panel in one round); got %d\n", grid); grid = -1; return; }
        fprintf(stderr, "kernel_launch: grid %d (cus %d, per_cu %d), ws %zu\n", grid, cus, per_cu, ws_size);
    }
    if (grid < 0) return;
    (void)hipMemsetAsync(d_ws, 0, 131072, stream);
    Args a{};
    const float** f = (const float**)&a;
    for (int i = 0; i < 20; ++i) f[i] = (const float*)d_in[i];
    a.out = (float*)d_out; a.ws = (unsigned char*)d_ws;
#ifndef PROBE
#define PROBE 0
#endif
    a.probe = PROBE; a.pad = 0;
    void* args[] = {&a};
    hipError_t e = hipLaunchCooperativeKernel((const void*)fwd_kernel, dim3(grid), dim3(512), args, LDS_BYTES, stream);
    if (e != hipSuccess) fprintf(stderr, "kernel_launch: cooperative launch failed: %s\n", hipGetErrorString(e));
}
```
